# Optimizing an MI355X kernel written in HIP

```python
import math
import jax
import jax.numpy as jnp
from jax import lax
import numpy as np

D_MODEL = 1024
BATCH = 32
SEQ = 256
DEPTH = 2
DEC_BATCH = 2
DEC_SEQ = 4096
PAST_LEN = 512

GRID_W = 64
HEAD_DIM = 64
D_FF = 2816
N_MOD = 9
W_POOL = D_MODEL // 2
W_CONV = D_MODEL - W_POOL
POOL_WINDOWS = (2, 4, 8, 16)
N_POOL_GROUPS = len(POOL_WINDOWS)
POOL_G = W_POOL // N_POOL_GROUPS
CONV_K = 3
W_NAT = D_MODEL // 2
W_DIFF = D_MODEL - W_NAT
H_NAT = W_NAT // HEAD_DIM
H_DIFF = W_DIFF // (2 * HEAD_DIM)
NAT_WIN_R = 8
NAT_WIN_C = 16
ROPE_THETA = 10000.0
Q_BLOCK = 128
N_EVEN = (DEPTH + 1) // 2
N_ODD = DEPTH // 2
EVEN_IN = W_POOL + 3 * W_CONV
ODD_IN = 3 * W_NAT + 3 * W_DIFF
ATTN_SCALE = HEAD_DIM ** -0.5
EPS = 1e-6

kernel_name = 'hybrid_pool_conv_nat_diff_prefix_dit_step'


def rmsnorm(x, g):
    xf = x.astype(jnp.float32)
    y = xf * lax.rsqrt(jnp.mean(xf * xf, axis=-1, keepdims=True) + EPS)
    return (y * g.astype(jnp.float32)).astype(x.dtype)


def adaln_mods(cond, mod_w, mod_b):
    m = jax.nn.silu(cond) @ mod_w + mod_b
    return jnp.split(m[:, None, :], N_MOD, axis=-1)


def modulated_norm(x, shift, scale, g):
    return rmsnorm(x, g) * (1.0 + scale) + shift


def swiglu(h, w_in, w_out):
    a, b = jnp.split(h @ w_in, 2, axis=-1)
    return (jax.nn.silu(a) * b) @ w_out


def ffn_half_step(x, mods, g, w_in, w_out):
    shift, scale, gate = mods
    return x + 0.5 * gate * swiglu(modulated_norm(x, shift, scale, g), w_in, w_out)


def pool_mixer(xa, pool_w, pool_scale):
    b, n, _ = xa.shape
    xg = xa.reshape(b, n, N_POOL_GROUPS, POOL_G)
    t = np.arange(n)[None, :]
    half = np.array(POOL_WINDOWS)[:, None] // 2
    lo = np.clip(t - half, 0, n - 1).T
    hi = np.clip(t + half - 1, 0, n - 1).T
    cnt = (hi - lo + 1).astype(np.float32)
    gidx = np.arange(N_POOL_GROUPS)[None, :]
    cs = jnp.pad(jnp.cumsum(xg.astype(jnp.float32), axis=1), ((0, 0), (1, 0), (0, 0), (0, 0)))
    win_sum = cs[:, hi + 1, gidx] - cs[:, lo, gidx]
    mean = win_sum / jnp.asarray(cnt)[None, :, :, None]
    d = (mean - xg.astype(jnp.float32)).astype(xa.dtype)
    y = jnp.einsum('bngc,gcd->bngd', d, pool_w)
    return y.reshape(b, n, W_POOL) * pool_scale


def short_conv_mixer(u, conv_w):
    h, gb, gc = jnp.split(u, 3, axis=-1)
    z = gc * h
    n = z.shape[1]
    zp = jnp.pad(z, ((0, 0), (CONV_K // 2, CONV_K // 2), (0, 0)))
    y = sum(zp[:, j:j + n] * conv_w[j] for j in range(CONV_K))
    return gb * y


def even_mixer(h, w_in, pool_w, pool_scale, conv_w, w_out):
    u = h @ w_in
    ya = pool_mixer(u[..., :W_POOL], pool_w, pool_scale)
    yb = short_conv_mixer(u[..., W_POOL:], conv_w)
    return jnp.concatenate([ya, yb], axis=-1) @ w_out


def axial_rope_tables(n):
    t = np.arange(n)
    row = (t // GRID_W).astype(np.float64)
    col = (t % GRID_W).astype(np.float64)
    quarter = HEAD_DIM // 4
    inv = 1.0 / (ROPE_THETA ** (np.arange(quarter) / quarter))
    ang = np.stack([row[:, None] * inv[None], col[:, None] * inv[None]], axis=1)
    return jnp.asarray(np.cos(ang).astype(np.float32)), jnp.asarray(np.sin(ang).astype(np.float32))


def apply_axial_rope(x, cos, sin):
    shp = x.shape
    xr = x.reshape(shp[:-1] + (2, 2, HEAD_DIM // 4)).astype(jnp.float32)
    c = cos[None, :, None, None]
    s = sin[None, :, None, None]
    x1, x2 = xr[..., 0, :], xr[..., 1, :]
    out = jnp.stack([x1 * c - x2 * s, x2 * c + x1 * s], axis=-2)
    return out.reshape(shp).astype(x.dtype)


def _split_blocks(q):
    b, n = q.shape[:2]
    return jnp.moveaxis(q.reshape((b, n // Q_BLOCK, Q_BLOCK) + q.shape[2:]), 1, 0)


def _merge_blocks(o):
    nb, b = o.shape[:2]
    return jnp.moveaxis(o, 0, 1).reshape((b, nb * Q_BLOCK) + o.shape[3:])


def softmax_attn(q, k, v):
    def one(qb):
        s = jnp.einsum('bqhd,bkhd->bhqk', qb, k).astype(jnp.float32)
        p = jax.nn.softmax(s, axis=-1).astype(v.dtype)
        return jnp.einsum('bhqk,bkhd->bqhd', p, v)
    return _merge_blocks(lax.map(one, _split_blocks(q)))


def diff_attn(q, k, v, lam):
    def one(qb):
        s = jnp.einsum('bqhjd,bkhjd->bhjqk', qb, k).astype(jnp.float32)
        p = jax.nn.softmax(s, axis=-1)
        a = (p[:, :, 0] - lam * p[:, :, 1]).astype(v.dtype)
        return jnp.einsum('bhqk,bkhe->bqhe', a, v)
    return _merge_blocks(lax.map(one, _split_blocks(q)))


def diff_lambda_value(lam_p, lam_init):
    lp = lam_p.astype(jnp.float32)
    return jnp.exp(jnp.sum(lp[0] * lp[1])) - jnp.exp(jnp.sum(lp[2] * lp[3])) + lam_init


def diff_heads_out(o, lam_init, g):
    b, n = o.shape[:2]
    return (rmsnorm(o, g) * (1.0 - lam_init)).reshape(b, n, W_DIFF)


def nat_latent_attn(q, k, v, kc, vc, rpb):
    b, n, h, d = q.shape
    rows = n // GRID_W
    wr = min(NAT_WIN_R, rows)
    r = np.arange(rows)
    r0 = np.clip(r - wr // 2, 0, rows - wr)
    key_rows = r0[:, None] + np.arange(wr)[None]
    col = np.arange(GRID_W)
    c0 = np.clip(col - NAT_WIN_C // 2, 0, GRID_W - NAT_WIN_C)
    key_cols = c0[:, None] + np.arange(NAT_WIN_C)[None]
    dr = key_rows - r[:, None] + (NAT_WIN_R - 1)
    dc = key_cols - col[:, None] + (NAT_WIN_C - 1)
    col_bias = rpb[:, :, dc]
    kg = k.reshape(b, rows, GRID_W, h, d)
    vg = v.reshape(b, rows, GRID_W, h, d)
    qg = jnp.moveaxis(q.reshape(b, rows, GRID_W, h, d), 1, 0)
    n_loc = wr * NAT_WIN_C

    def one(args):
        q_row, kr, drr = args
        k_win = jnp.take(jnp.take(kg, kr, axis=1), key_cols, axis=2)
        v_win = jnp.take(jnp.take(vg, kr, axis=1), key_cols, axis=2)
        bias = jnp.moveaxis(jnp.take(col_bias, drr, axis=1), 1, 2)
        s_loc = jnp.einsum('bqhd,brqkhd->bhqrk', q_row, k_win).astype(jnp.float32) + bias[None].astype(jnp.float32)
        s_ctx = jnp.einsum('bqhd,bmhd->bhqm', q_row, kc).astype(jnp.float32)
        p = jax.nn.softmax(jnp.concatenate([s_loc.reshape(b, h, GRID_W, n_loc), s_ctx], axis=-1), axis=-1)
        p_loc = p[..., :n_loc].reshape(b, h, GRID_W, wr, NAT_WIN_C).astype(v.dtype)
        p_ctx = p[..., n_loc:].astype(v.dtype)
        return (jnp.einsum('bhqrk,brqkhd->bqhd', p_loc, v_win)
                + jnp.einsum('bhqm,bmhd->bqhd', p_ctx, vc))

    out = lax.map(one, (qg, jnp.asarray(key_rows, jnp.int32), jnp.asarray(dr, jnp.int32)))
    return jnp.moveaxis(out, 0, 1).reshape(b, n, h, d)


def odd_project(h, w_in):
    b, n, _ = h.shape
    cuts = np.cumsum([W_NAT, W_NAT, W_NAT, W_DIFF, W_DIFF]).tolist()
    nq, nk, nv, dq, dk, dv = jnp.split(h @ w_in, cuts, axis=-1)
    return (nq.reshape(b, n, H_NAT, HEAD_DIM), nk.reshape(b, n, H_NAT, HEAD_DIM),
            nv.reshape(b, n, H_NAT, HEAD_DIM), dq.reshape(b, n, H_DIFF, 2, HEAD_DIM),
            dk.reshape(b, n, H_DIFF, 2, HEAD_DIM), dv.reshape(b, n, H_DIFF, 2 * HEAD_DIM))


def odd_mixer_context(h, w_in, lam_p, dnorm, w_out, layer_idx):
    b, n, _ = h.shape
    nq, nk, nv, dq, dk, dv = odd_project(h, w_in)
    lam_init = 0.8 - 0.6 * math.exp(-0.3 * layer_idx)
    lam = diff_lambda_value(lam_p, lam_init)
    o_nat = softmax_attn(nq * ATTN_SCALE, nk, nv).reshape(b, n, W_NAT)
    o_diff = diff_heads_out(diff_attn(dq * ATTN_SCALE, dk, dv, lam), lam_init, dnorm)
    y = jnp.concatenate([o_nat, o_diff], axis=-1) @ w_out
    return y, nk, nv, dk, dv


def odd_mixer_latent(h, kc, vc, dkc, dvc, w_in, rpb, lam_p, dnorm, w_out, layer_idx, cos, sin):
    b, n, _ = h.shape
    nq, nk, nv, dq, dk, dv = odd_project(h, w_in)
    dq = apply_axial_rope(dq, cos, sin)
    dk = apply_axial_rope(dk, cos, sin)
    lam_init = 0.8 - 0.6 * math.exp(-0.3 * layer_idx)
    lam = diff_lambda_value(lam_p, lam_init)
    o_nat = nat_latent_attn(nq * ATTN_SCALE, nk, nv, kc, vc, rpb).reshape(b, n, W_NAT)
    k_all = jnp.concatenate([dk, dkc], axis=1)
    v_all = jnp.concatenate([dv, dvc], axis=1)
    o_diff = diff_heads_out(diff_attn(dq * ATTN_SCALE, k_all, v_all, lam), lam_init, dnorm)
    return jnp.concatenate([o_nat, o_diff], axis=-1) @ w_out


def setup_inputs(seed: int = 0) -> dict:
    key = jax.random.key(seed)
    ks = jax.random.split(key, 32)
    f32 = jnp.float32
    D = D_MODEL

    def nrm(k, shape, scale):
        return jax.random.normal(k, shape, f32) * scale

    def gain(k, shape):
        return 1.0 + 0.02 * jax.random.normal(k, shape, f32)

    return {
        'x_prompt': nrm(ks[0], (BATCH, SEQ, D), 1.0),
        'x_sample': nrm(ks[1], (DEC_BATCH, DEC_SEQ, D), 1.0),
        'cache_nat_k': nrm(ks[2], (DEC_BATCH, N_ODD, PAST_LEN, H_NAT, HEAD_DIM), 1.0),
        'cache_nat_v': nrm(ks[3], (DEC_BATCH, N_ODD, PAST_LEN, H_NAT, HEAD_DIM), 1.0),
        'cache_diff_k': nrm(ks[4], (DEC_BATCH, N_ODD, PAST_LEN, H_DIFF, 2, HEAD_DIM), 1.0),
        'cache_diff_v': nrm(ks[5], (DEC_BATCH, N_ODD, PAST_LEN, H_DIFF, 2 * HEAD_DIM), 1.0),
        'c': nrm(ks[6], (DEC_BATCH, D), 1.0),
        'c_ctx': nrm(ks[7], (D,), 1.0),
        'mod_w': nrm(ks[8], (DEPTH, D, N_MOD * D), 0.5 * D ** -0.5),
        'mod_b': nrm(ks[9], (DEPTH, N_MOD * D), 0.01),
        'norm_ffn1': gain(ks[10], (DEPTH, D)),
        'ffn1_w_in': nrm(ks[11], (DEPTH, D, 2 * D_FF), D ** -0.5),
        'ffn1_w_out': nrm(ks[12], (DEPTH, D_FF, D), D_FF ** -0.5),
        'norm_mix': gain(ks[13], (DEPTH, D)),
        'even_w_in': nrm(ks[14], (N_EVEN, D, EVEN_IN), D ** -0.5),
        'pool_w': nrm(ks[15], (N_EVEN, N_POOL_GROUPS, POOL_G, POOL_G), POOL_G ** -0.5),
        'pool_scale': gain(ks[16], (N_EVEN, W_POOL)),
        'conv_w': nrm(ks[17], (N_EVEN, CONV_K, W_CONV), CONV_K ** -0.5),
        'odd_w_in': nrm(ks[18], (N_ODD, D, ODD_IN), D ** -0.5),
        'nat_rpb': nrm(ks[19], (N_ODD, H_NAT, 2 * NAT_WIN_R - 1, 2 * NAT_WIN_C - 1), 0.1),
        'diff_lambda': nrm(ks[20], (N_ODD, 4, HEAD_DIM), 0.1),
        'diff_norm': gain(ks[21], (N_ODD, 2 * HEAD_DIM)),
        'mix_w_out': nrm(ks[22], (DEPTH, D, D), D ** -0.5),
        'norm_ffn2': gain(ks[23], (DEPTH, D)),
        'ffn2_w_in': nrm(ks[24], (DEPTH, D, 2 * D_FF), D ** -0.5),
        'ffn2_w_out': nrm(ks[25], (DEPTH, D_FF, D), D_FF ** -0.5),
        'final_norm': gain(ks[26], (D,)),
    }


def reference(x_prompt, x_sample, cache_nat_k, cache_nat_v, cache_diff_k, cache_diff_v, c, c_ctx,
              mod_w, mod_b, norm_ffn1, ffn1_w_in, ffn1_w_out, norm_mix, even_w_in, pool_w,
              pool_scale, conv_w, odd_w_in, nat_rpb, diff_lambda, diff_norm, mix_w_out,
              norm_ffn2, ffn2_w_in, ffn2_w_out, final_norm):
    cos, sin = axial_rope_tables(x_sample.shape[1])
    ctx, lat = x_prompt, x_sample
    new_nk, new_nv, new_dk, new_dv = [], [], [], []
    for l in range(DEPTH):
        m_ctx = adaln_mods(c_ctx[None, :], mod_w[l], mod_b[l])
        m_lat = adaln_mods(c, mod_w[l], mod_b[l])
        ctx = ffn_half_step(ctx, m_ctx[0:3], norm_ffn1[l], ffn1_w_in[l], ffn1_w_out[l])
        lat = ffn_half_step(lat, m_lat[0:3], norm_ffn1[l], ffn1_w_in[l], ffn1_w_out[l])
        h_ctx = modulated_norm(ctx, m_ctx[3], m_ctx[4], norm_mix[l])
        h_lat = modulated_norm(lat, m_lat[3], m_lat[4], norm_mix[l])
        if l % 2 == 0:
            e = l // 2
            y_ctx = even_mixer(h_ctx, even_w_in[e], pool_w[e], pool_scale[e], conv_w[e], mix_w_out[l])
            y_lat = even_mixer(h_lat, even_w_in[e], pool_w[e], pool_scale[e], conv_w[e], mix_w_out[l])
        else:
            o = l // 2
            y_ctx, nk, nv, dk, dv = odd_mixer_context(h_ctx, odd_w_in[o], diff_lambda[o], diff_norm[o],
                                                      mix_w_out[l], l)
            new_nk.append(nk)
            new_nv.append(nv)
            new_dk.append(dk)
            new_dv.append(dv)
            y_lat = odd_mixer_latent(h_lat, cache_nat_k[:, o], cache_nat_v[:, o], cache_diff_k[:, o],
                                     cache_diff_v[:, o], odd_w_in[o], nat_rpb[o], diff_lambda[o],
                                     diff_norm[o], mix_w_out[l], l, cos, sin)
        ctx = ctx + m_ctx[5] * y_ctx
        lat = lat + m_lat[5] * y_lat
        ctx = ffn_half_step(ctx, m_ctx[6:9], norm_ffn2[l], ffn2_w_in[l], ffn2_w_out[l])
        lat = ffn_half_step(lat, m_lat[6:9], norm_ffn2[l], ffn2_w_in[l], ffn2_w_out[l])
    y_prompt = rmsnorm(ctx, final_norm)
    y_sample = rmsnorm(lat, final_norm)
    new_nat_k = jnp.stack(new_nk, axis=1)
    new_nat_v = jnp.stack(new_nv, axis=1)
    new_diff_k = jnp.stack(new_dk, axis=1)
    new_diff_v = jnp.stack(new_dv, axis=1)
    return (y_prompt, y_sample, new_nat_k, new_nat_v, new_diff_k, new_diff_v)
```

```cpp
#include <hip/hip_runtime.h>
#include <hip/hip_cooperative_groups.h>
#include <cstdio>
#include <cstdint>
namespace cg = cooperative_groups;
namespace pg8 {
#define PG8_LAS __attribute__((address_space(3)))
typedef unsigned short bf16_t;
typedef short bf16x8 __attribute__((ext_vector_type(8)));
typedef float f32x4 __attribute__((ext_vector_type(4)));
typedef unsigned u32x4 __attribute__((ext_vector_type(4)));
constexpr int BM = 256, BK = 64, HALF = 128, HTB = HALF * BK * 2  , STAGE_BYTES = 8 * HTB, NXCD = 8, WGM = 8;

__host__ __device__ __forceinline__ int lds_byte(int r, int c) { const int st = (r >> 4) * 2 + (c >> 5), rr = r & 15, cc = c & 31, ob = rr * 64 + cc * 2; return st * 1024 + (ob ^ (((ob >> 9) & 1) << 5)); }
__host__ __device__ __forceinline__ void stage_rc(int b, int& R, int& C) { const int st = b / 1024, sb = b % 1024, swz = sb ^ (((sb >> 9) & 1) << 5); R = (st >> 1) * 16 + swz / 64; C = (st & 1) * 32 + (swz % 64) / 2; }
__host__ __device__ __forceinline__ int perm32(int rho) { const int n = rho >> 4, i = rho & 15; return 8 * (i >> 2) + 4 * n + (i & 3); }

struct Unit { int pm, pn; };
struct Gemm { const bf16_t* A; const bf16_t* Bt; int M, N, K; };

struct StaticOrder {
    int nM, nN, nwg, G, c;
    __host__ __device__ void init(int M, int N, int G_, int c_) { nM = M / BM; nN = N / BM; nwg = nM * nN; G = G_; c = c_; }
    __host__ __device__ bool next(int i, Unit& u) const {
        const long L = (long)i * G + c; if (L >= nwg) return false;
        int wgid = (int)L; { const int q = nwg / NXCD, r = nwg % NXCD, xcd = wgid % NXCD, off = wgid / NXCD; wgid = (xcd < r ? xcd * (q + 1) : r * (q + 1) + (xcd - r) * q) + off; }
        const int nig = WGM * nN, gid = wgid / nig, fm = gid * WGM, gsz = (nM - fm) < WGM ? (nM - fm) : WGM;
        u.pm = fm + ((wgid % nig) % gsz); u.pn = (wgid % nig) / gsz; return true;
    }
    __device__ __forceinline__ void a_ready(const Unit&) const {}
    __device__ __forceinline__ void done(const Unit&) const {}
};
__device__ __forceinline__ unsigned cvt_pk_bf16(float lo, float hi) { unsigned r; asm volatile("v_cvt_pk_bf16_f32 %0, %1, %2" : "=v"(r) : "v"(lo), "v"(hi)); return r; }
template <class Epi, class Sched, bool ALIGN_EPI = false, bool SP2 = false>
__device__ __forceinline__ void gemm_phase(PG8_LAS unsigned char* lds, const Gemm g, const Sched& S, const Epi& E) {
    int tid_ = threadIdx.x; asm volatile("" : "+v"(tid_));
    const int tid = tid_, wid = __builtin_amdgcn_readfirstlane(tid >> 6), lane = tid & 63, wr = wid >> 2, wc = wid & 3, fr = lane & 15, fq = lane >> 4;
    const int K = g.K, nt = K / BK;
    unsigned voffA[2], voffB[2];
#pragma unroll
    for (int i = 0; i < 2; ++i) { int R, C; stage_rc(tid * 16 + i * 8192, R, C); const int Rb = Epi::PERM ? ((R & ~31) + perm32(R & 31)) : R;
        voffA[i] = (unsigned)(R * K + C) * 2u; voffB[i] = (unsigned)(Rb * K + C) * 2u; }
    const size_t kstep = (size_t)(BK * 2);
    const size_t hstep = (size_t)HALF * K * 2;
    const size_t tstep = 2 * hstep;
    const unsigned ldsw = (unsigned)wid * 1024u;
    const int aoff = lds_byte(wr * 64 + fr, fq * 8), boff = lds_byte(wc * 32 + fr, fq * 8);
#define PG8_SA(b, h) (((b) * 2 + (h)) * HTB)
#define PG8_SB(b, h) ((4 + (b) * 2 + (h)) * HTB)
#define PG8_STAGE(bufoff, gbase, voff) do { _Pragma("unroll") for (int _i = 0; _i < 2; ++_i) \
        __builtin_amdgcn_global_load_lds((const unsigned*)((const char*)(gbase) + (voff)[_i]), (PG8_LAS unsigned*)(lds + (bufoff) + ldsw + _i * 8192), 16, 0, 0); } while (0)
#define PG8_LDA(dst, b, h) do { _Pragma("unroll") for (int m = 0; m < 4; ++m) _Pragma("unroll") for (int k = 0; k < 2; ++k) dst[m][k] = *(const PG8_LAS bf16x8*)(lds + PG8_SA(b, h) + aoff + m * 2048 + k * 1024); } while (0)
#define PG8_LDB(dst, b, h) do { _Pragma("unroll") for (int n = 0; n < 2; ++n) _Pragma("unroll") for (int k = 0; k < 2; ++k) dst[n][k] = *(const PG8_LAS bf16x8*)(lds + PG8_SB(b, h) + boff + n * 2048 + k * 1024); } while (0)
#define PG8_MMA(ai, bj, At, Bt) do { __builtin_amdgcn_s_setprio(1); _Pragma("unroll") for (int m = 0; m < 4; ++m) _Pragma("unroll") for (int n = 0; n < 2; ++n) _Pragma("unroll") for (int k = 0; k < 2; ++k) \
        acc[ai][bj][m][n] = __builtin_amdgcn_mfma_f32_16x16x32_bf16(Bt[n][k], At[m][k], acc[ai][bj][m][n], 0, 0, 0); __builtin_amdgcn_s_setprio(0); } while (0)
#define PG8_WAIT_V(n) asm volatile("s_waitcnt vmcnt(" #n ")" ::: "memory")
#define PG8_WAIT_L(n) asm volatile("s_waitcnt lgkmcnt(" #n ")" ::: "memory")
#define PG8_BAR __builtin_amdgcn_s_barrier()
#define PG8_SCHED __builtin_amdgcn_sched_barrier(0)
    Unit cur, nxt; int ui = 0;
    if (!S.next(0, cur)) return;
    f32x4 acc[2][2][4][2];
#pragma unroll
    for (int a = 0; a < 2; ++a)
#pragma unroll
        for (int b = 0; b < 2; ++b)
#pragma unroll
            for (int m = 0; m < 4; ++m)
#pragma unroll
                for (int n = 0; n < 2; ++n) acc[a][b][m][n] = (f32x4){0.f, 0.f, 0.f, 0.f};
    bf16x8 At[4][2], B0[2][2], B1[2][2];
    const char* cA = (const char*)g.A + (size_t)cur.pm * tstep; const char* cB = (const char*)g.Bt + (size_t)cur.pn * tstep;
    S.a_ready(cur);
    if constexpr (SP2) {
        PG8_STAGE(PG8_SB(0, 0), cB, voffB); PG8_STAGE(PG8_SB(0, 1), cB + hstep, voffB); PG8_STAGE(PG8_SA(0, 0), cA, voffA); PG8_STAGE(PG8_SA(0, 1), cA + hstep, voffA);
        if (wr == 1) PG8_BAR;
        PG8_WAIT_V(2); PG8_BAR;
        PG8_STAGE(PG8_SB(1, 0), cB + kstep, voffB); PG8_STAGE(PG8_SA(1, 0), cA + kstep, voffA); PG8_STAGE(PG8_SB(1, 1), cB + hstep + kstep, voffB);
        PG8_WAIT_V(6); PG8_BAR;
    } else {
        PG8_STAGE(PG8_SB(0, 0), cB, voffB); PG8_STAGE(PG8_SA(0, 0), cA, voffA); PG8_STAGE(PG8_SB(0, 1), cB + hstep, voffB); PG8_STAGE(PG8_SA(0, 1), cA + hstep, voffA);
        if (wr == 1) PG8_BAR;
        PG8_WAIT_V(4); PG8_BAR;
        PG8_STAGE(PG8_SB(1, 0), cB + kstep, voffB); PG8_STAGE(PG8_SA(1, 0), cA + kstep, voffA); PG8_STAGE(PG8_SB(1, 1), cB + hstep + kstep, voffB);
        PG8_WAIT_V(6); PG8_BAR;
    }
    for (;;) {
        const bool has_next = S.next(ui + 1, nxt);
        const char* nA = has_next ? (const char*)g.A + (size_t)nxt.pm * tstep : cA; const char* nB = has_next ? (const char*)g.Bt + (size_t)nxt.pn * tstep : cB;
        for (int t = 0; t < nt; t += 2) {
            const bool last = (t == nt - 2);
            const char* a1 = cA + (size_t)(t + 1) * kstep;
            const char* a2 = last ? nA : cA + (size_t)(t + 2) * kstep; const char* b2 = last ? nB : cB + (size_t)(t + 2) * kstep;
            const char* a3 = a2 + kstep; const char* b3 = b2 + kstep;
            if (last && has_next) S.a_ready(nxt);
            if constexpr (SP2) {
            PG8_LDB(B0, 0, 0); PG8_LDB(B1, 0, 1); PG8_SCHED; PG8_LDA(At, 0, 0); PG8_STAGE(PG8_SA(1, 1), a1 + hstep, voffA);
            PG8_WAIT_V(8); PG8_WAIT_L(0); PG8_BAR; PG8_MMA(0, 0, At, B0); PG8_MMA(0, 1, At, B1); PG8_BAR; PG8_SCHED;
            PG8_LDA(At, 0, 1); PG8_STAGE(PG8_SB(0, 0), b2, voffB); PG8_STAGE(PG8_SB(0, 1), b2 + hstep, voffB); PG8_STAGE(PG8_SA(0, 0), a2, voffA);
            PG8_WAIT_V(8); PG8_WAIT_L(0); PG8_BAR; PG8_MMA(1, 0, At, B0); PG8_MMA(1, 1, At, B1); PG8_BAR; PG8_SCHED;
            PG8_LDB(B0, 1, 0); PG8_LDB(B1, 1, 1); PG8_SCHED; PG8_LDA(At, 1, 0); PG8_STAGE(PG8_SA(0, 1), a2 + hstep, voffA);
            PG8_WAIT_V(8); PG8_WAIT_L(0); PG8_BAR; PG8_MMA(0, 0, At, B0); PG8_MMA(0, 1, At, B1); PG8_BAR; PG8_SCHED;
            PG8_LDA(At, 1, 1); PG8_STAGE(PG8_SB(1, 0), b3, voffB); PG8_STAGE(PG8_SB(1, 1), b3 + hstep, voffB); PG8_STAGE(PG8_SA(1, 0), a3, voffA);
            PG8_WAIT_V(8); PG8_WAIT_L(0); PG8_BAR; PG8_MMA(1, 0, At, B0); PG8_MMA(1, 1, At, B1); PG8_BAR; PG8_SCHED;
            } else {
            PG8_LDB(B0, 0, 0); PG8_SCHED; PG8_LDA(At, 0, 0); PG8_STAGE(PG8_SA(1, 1), a1 + hstep, voffA);
            PG8_WAIT_L(8); PG8_BAR; PG8_WAIT_L(0); PG8_MMA(0, 0, At, B0); PG8_BAR; PG8_SCHED;
            PG8_LDB(B1, 0, 1); PG8_STAGE(PG8_SB(0, 0), b2, voffB);
            PG8_BAR; PG8_WAIT_L(0); PG8_MMA(0, 1, At, B1); PG8_BAR;
            PG8_LDA(At, 0, 1); PG8_STAGE(PG8_SA(0, 0), a2, voffA);
            PG8_BAR; PG8_WAIT_L(0); PG8_MMA(1, 0, At, B0); PG8_BAR; PG8_SCHED;
            PG8_STAGE(PG8_SB(0, 1), b2 + hstep, voffB);
            PG8_WAIT_V(6); PG8_BAR; PG8_MMA(1, 1, At, B1); PG8_BAR;
            PG8_LDB(B0, 1, 0); PG8_SCHED; PG8_LDA(At, 1, 0); PG8_STAGE(PG8_SA(0, 1), a2 + hstep, voffA);
            PG8_WAIT_L(8); PG8_BAR; PG8_WAIT_L(0); PG8_MMA(0, 0, At, B0); PG8_BAR; PG8_SCHED;
            PG8_LDB(B1, 1, 1); PG8_STAGE(PG8_SB(1, 0), b3, voffB);
            PG8_BAR; PG8_WAIT_L(0); PG8_MMA(0, 1, At, B1); PG8_BAR;
            PG8_LDA(At, 1, 1); PG8_STAGE(PG8_SA(1, 0), a3, voffA);
            PG8_BAR; PG8_WAIT_L(0); PG8_MMA(1, 0, At, B0); PG8_BAR; PG8_SCHED;
            PG8_STAGE(PG8_SB(1, 1), b3 + hstep, voffB);
            PG8_WAIT_V(6); PG8_BAR; PG8_MMA(1, 1, At, B1); PG8_BAR;
            }
        }
        if constexpr (ALIGN_EPI) { if (wr == 0) PG8_BAR; }
        if constexpr (!Epi::AFTER_DRAIN) { E(acc, cur, wr, wc, fr, fq); S.done(cur); }
        if (!has_next) break;
#pragma unroll
        for (int a = 0; a < 2; ++a)
#pragma unroll
            for (int b = 0; b < 2; ++b)
#pragma unroll
                for (int m = 0; m < 4; ++m)
#pragma unroll
                    for (int n = 0; n < 2; ++n) acc[a][b][m][n] = (f32x4){0.f, 0.f, 0.f, 0.f};
        cur = nxt; cA = nA; cB = nB; ++ui;
        if constexpr (ALIGN_EPI) { if (wr == 1) PG8_BAR; }
    }
    PG8_WAIT_V(0);
    if constexpr (!ALIGN_EPI) { if (wr == 0) PG8_BAR; }
    PG8_BAR;
    if constexpr (Epi::AFTER_DRAIN) { E.fused(acc, cur, wr, wc, fr, fq, lds, wid, lane); S.done(cur); }
#undef PG8_SA
#undef PG8_SB
#undef PG8_STAGE
#undef PG8_LDA
#undef PG8_LDB
#undef PG8_MMA
#undef PG8_WAIT_V
#undef PG8_WAIT_L
#undef PG8_BAR
#undef PG8_SCHED
}
}

#define LAS __attribute__((address_space(3)))
typedef unsigned short bf16;
typedef short bf16x8 __attribute__((ext_vector_type(8)));
typedef float f32x4 __attribute__((ext_vector_type(4)));
typedef float f32x16 __attribute__((ext_vector_type(16)));
typedef unsigned u32x4 __attribute__((ext_vector_type(4)));
typedef unsigned u32x2 __attribute__((ext_vector_type(2)));
typedef short s16x4 __attribute__((ext_vector_type(4)));

constexpr int D = 1024, FF = 2816, M = 16384, MCTX = 8192, NMOD = 9216;
constexpr int NWAVES = 8, NTHR = 512;
constexpr float LOG2E = 1.4426950408889634f;
constexpr float QSCALE = 0.125f * LOG2E;
constexpr float LAM_INIT = 0.35550906759096934f;
constexpr float EPS = 1e-6f;

constexpr size_t MiB = 1u << 20;
constexpr size_t WS_MODS = 1 * MiB;
constexpr size_t WS_ROPE = 1 * MiB + 512 * 1024;
constexpr size_t WS_CACHE = 2 * MiB;
constexpr size_t WS_WF = 8 * MiB;
constexpr size_t WS_WMI0 = 76 * MiB, WS_WMI1 = 80 * MiB, WS_WMO0 = 86 * MiB, WS_WMO1 = 88 * MiB;
constexpr size_t WS_H = 96 * MiB, WS_Y = 128 * MiB, WS_ACT = 160 * MiB, WS_END = 256 * MiB;

constexpr int LDS_BYTES = 147456;

__device__ const double ROPE_INV[16] = {1.0, 0.5623413251903491, 0.31622776601683794, 0.1778279410038923, 0.1, 0.05623413251903491, 0.03162277660168379,
    0.01778279410038923, 0.01, 0.005623413251903491, 0.0031622776601683794, 0.0017782794100389228, 0.001, 0.0005623413251903491, 0.00031622776601683794, 0.00017782794100389227};

struct Args { const float* in[27]; float* out; unsigned char* ws; };

__device__ __forceinline__ float wave_sum(float v) {
#pragma unroll
    for (int o = 1; o < 64; o <<= 1) v += __shfl_xor(v, o);
    return v;
}
__device__ __forceinline__ unsigned pk2(float lo, float hi) { return pg8::cvt_pk_bf16(lo, hi); }
__device__ __forceinline__ float bf_lo(unsigned w) { return __uint_as_float(w << 16); }
__device__ __forceinline__ float bf_hi(unsigned w) { return __uint_as_float(w & 0xffff0000u); }
__device__ __forceinline__ float fast_exp2(float x) { return __builtin_amdgcn_exp2f(x); }
__device__ __forceinline__ float silu_f(float x) { return x * __builtin_amdgcn_rcpf(1.0f + fast_exp2(-x * LOG2E)); }
__device__ __forceinline__ int cond_of_row(int row) { return row < MCTX ? 0 : 1 + ((row - MCTX) >> 12); }

struct EpiSwiglu {
    static constexpr bool PERM = true, AFTER_DRAIN = false;
    bf16* O;
    __device__ __forceinline__ void operator()(const f32x4 (&acc)[2][2][4][2], const pg8::Unit& u, int wr, int wc, int fr_, int fq_) const {
        int fr = fr_, fq = fq_; asm volatile("" : "+v"(fr), "+v"(fq));
        const int row0 = u.pm * 256 + wr * 64 + fr, col0 = u.pn * 128 + wc * 32 + 8 * fq;
#pragma unroll
        for (int ai = 0; ai < 2; ++ai)
#pragma unroll
            for (int m = 0; m < 4; ++m) {
                bf16* rowp = O + (size_t)(row0 + ai * 128 + m * 16) * FF + col0;
                const f32x4 a0 = acc[ai][0][m][0], a1 = acc[ai][0][m][1], b0 = acc[ai][1][m][0], b1 = acc[ai][1][m][1];
                u32x4 w;
                w.x = pk2(silu_f(a0[0]) * b0[0], silu_f(a0[1]) * b0[1]); w.y = pk2(silu_f(a0[2]) * b0[2], silu_f(a0[3]) * b0[3]);
                w.z = pk2(silu_f(a1[0]) * b1[0], silu_f(a1[1]) * b1[1]); w.w = pk2(silu_f(a1[2]) * b1[2], silu_f(a1[3]) * b1[3]);
                *(u32x4*)rowp = w;
            }
    }
};
struct EpiBf16P {
    static constexpr bool PERM = true, AFTER_DRAIN = false;
    bf16* O; int ldc;
    __device__ __forceinline__ void operator()(const f32x4 (&acc)[2][2][4][2], const pg8::Unit& u, int wr, int wc, int fr_, int fq_) const {
        int fr = fr_, fq = fq_; asm volatile("" : "+v"(fr), "+v"(fq));
        const int row0 = u.pm * 256 + wr * 64 + fr, col0 = u.pn * 256 + wc * 32 + 8 * fq;
#pragma unroll
        for (int ai = 0; ai < 2; ++ai)
#pragma unroll
            for (int m = 0; m < 4; ++m) {
                bf16* rowp = O + (size_t)(row0 + ai * 128 + m * 16) * ldc + col0;
#pragma unroll
                for (int bj = 0; bj < 2; ++bj) {
                    const f32x4 v0 = acc[ai][bj][m][0], v1 = acc[ai][bj][m][1];
                    u32x4 w; w.x = pk2(v0[0], v0[1]); w.y = pk2(v0[2], v0[3]); w.z = pk2(v1[0], v1[1]); w.w = pk2(v1[2], v1[3]);
                    *(u32x4*)(rowp + bj * 128) = w;
                }
            }
    }
};
struct EpiResid {
    static constexpr bool PERM = false, AFTER_DRAIN = false;
    const float* base_c; const float* base_l; float* X; const float* gate; float gs;
    __device__ __forceinline__ void operator()(const f32x4 (&acc)[2][2][4][2], const pg8::Unit& u, int wr, int wc, int fr_, int fq_) const {
        int fr = fr_, fq = fq_; asm volatile("" : "+v"(fr), "+v"(fq));
        const int rowt = u.pm * 256, row0 = rowt + wr * 64 + fr, col0 = u.pn * 256 + wc * 32 + 4 * fq;
        const float* gp = gate + (size_t)cond_of_row(rowt) * NMOD + col0;
        const float* bp = rowt < MCTX ? base_c + (size_t)row0 * D : base_l + (size_t)(row0 - MCTX) * D;
        float* xp = X + (size_t)row0 * D + col0;
        bp += col0;
        f32x4 gv[2][2];
#pragma unroll
        for (int bj = 0; bj < 2; ++bj)
#pragma unroll
            for (int n = 0; n < 2; ++n) gv[bj][n] = *(const f32x4*)(gp + bj * 128 + n * 16) * gs;
#pragma unroll
        for (int ai = 0; ai < 2; ++ai)
#pragma unroll
            for (int m = 0; m < 4; ++m) {
                const size_t ro = (size_t)(ai * 128 + m * 16) * D;
#pragma unroll
                for (int bj = 0; bj < 2; ++bj)
#pragma unroll
                    for (int n = 0; n < 2; ++n) {
                        const f32x4 b = *(const f32x4*)(bp + ro + bj * 128 + n * 16);
                        *(f32x4*)(xp + ro + bj * 128 + n * 16) = b + gv[bj][n] * acc[ai][bj][m][n];
                    }
            }
    }
};
struct EpiOdd {
    static constexpr bool PERM = false, AFTER_DRAIN = false;
    bf16* U; float* newc; const float* rope;
    __device__ __forceinline__ void operator()(const f32x4 (&acc)[2][2][4][2], const pg8::Unit& u, int wr, int wc, int fr_, int fq_) const {
        int fr = fr_, fq = fq_; asm volatile("" : "+v"(fr), "+v"(fq));
        const int rowt = u.pm * 256, row0 = rowt + wr * 64 + fr, pn = u.pn;
        const int colt = pn * 256 + wc * 32 + 4 * fq;
        const bool ctx = rowt < MCTX;
        const float sc = (pn < 2 || (pn == 6 || pn == 7)) ? QSCALE : 1.0f;
        const bool do_rope = (!ctx) && (pn >= 6 && pn <= 9);
        const int oidx = (pn == 2 || pn == 3) ? 0 : (pn == 4 || pn == 5) ? 1 : (pn == 8 || pn == 9) ? 2 : (pn >= 10) ? 3 : -1;
        float* np = newc + (size_t)(oidx < 0 ? 0 : oidx) * ((size_t)MCTX * 512) + (size_t)(pn & 1) * 256 + wc * 32 + 4 * fq;
#pragma unroll
        for (int ai = 0; ai < 2; ++ai)
#pragma unroll
            for (int m = 0; m < 4; ++m) {
                const int row = row0 + ai * 128 + m * 16;
                bf16* up = U + (size_t)row * 3072 + colt;
                f32x4 cs = {1.f, 1.f, 1.f, 1.f}, sn = {0.f, 0.f, 0.f, 0.f};
                if (do_rope) {
                    const int t = (row - MCTX) & 4095;
                    const int pos = (wc & 1) ? (t & 63) : (t >> 6);
                    cs = *(const f32x4*)(rope + pos * 16 + 4 * fq); sn = *(const f32x4*)(rope + 1024 + pos * 16 + 4 * fq);
                }
#pragma unroll
                for (int bj = 0; bj < 2; ++bj) {
                    const f32x4 x1 = acc[ai][bj][m][0], x2 = acc[ai][bj][m][1];
                    if (ctx && oidx >= 0) {
                        *(f32x4*)(np + (size_t)row * 512 + bj * 128) = x1;
                        *(f32x4*)(np + (size_t)row * 512 + bj * 128 + 16) = x2;
                    }
                    const f32x4 o1 = (x1 * cs - x2 * sn) * sc, o2 = (x2 * cs + x1 * sn) * sc;
                    u32x2 w1, w2; w1.x = pk2(o1[0], o1[1]); w1.y = pk2(o1[2], o1[3]); w2.x = pk2(o2[0], o2[1]); w2.y = pk2(o2[2], o2[3]);
                    *(u32x2*)(up + bj * 128) = w1; *(u32x2*)(up + bj * 128 + 16) = w2;
                }
            }
    }
};

template <class Epi> __device__ __forceinline__ void run_gemm(LAS unsigned char* lds, const bf16* A, const bf16* Bt, int N, int K, const Epi& E) {
    pg8::Gemm g{A, Bt, M, N, K}; pg8::StaticOrder S; S.init(M, N, (int)gridDim.x, (int)blockIdx.x);
    pg8::gemm_phase<Epi, pg8::StaticOrder, true, true>(lds, g, S, E);
}

__device__ __forceinline__ void tr_item(const float* W, int N, bf16* WT, int ldt, int k0, int n0, int dst_row0, LAS float* scr, int lane) {
#pragma unroll 8
    for (int i = 0; i < 32; ++i) { const int kk = 2 * i + (lane >> 5); scr[kk * 33 + (lane & 31)] = W[(size_t)(k0 + kk) * N + n0 + (lane & 31)]; }
    asm volatile("s_waitcnt lgkmcnt(0)" ::: "memory");
    const int c = lane & 7;
#pragma unroll
    for (int j = 0; j < 4; ++j) { const int n = (lane >> 3) + 8 * j; const LAS float* s = scr + (8 * c) * 33 + n;
        u32x4 o; o.x = pk2(s[0 * 33], s[1 * 33]); o.y = pk2(s[2 * 33], s[3 * 33]); o.z = pk2(s[4 * 33], s[5 * 33]); o.w = pk2(s[6 * 33], s[7 * 33]);
        *(u32x4*)(WT + (size_t)(dst_row0 + n) * ldt + k0 + 8 * c) = o; }
    asm volatile("s_waitcnt lgkmcnt(0)" ::: "memory");
}
__device__ __forceinline__ int swiglu_row(int n0) { return n0 < FF ? 256 * (n0 >> 7) + (n0 & 127) : 256 * ((n0 - FF) >> 7) + 128 + ((n0 - FF) & 127); }

__device__ __forceinline__ void p0_weights(const Args& a, LAS unsigned char* lds, int gw, int NGW, int wave, int lane) {
    asm volatile("" : "+v"(lane));
    LAS float* scr = (LAS float*)(lds + wave * 16384);
    unsigned char* ws = a.ws;
    constexpr int I_IN = 16 * 176, I_OUT = 44 * 32, I_LF = I_IN + I_OUT, I_FFN = 4 * I_LF;
    constexpr int I_EV = 16 * 64, I_OD = 16 * 96, I_MO0 = 8 * 32, I_MO1 = 16 * 32;
    constexpr int NITEMS = I_FFN + I_EV + I_OD + I_MO0 + I_MO1;
    for (int it = gw; it < NITEMS; it += NGW) {
        int r = it;
        if (r < I_FFN) {
            const int lf = r / I_LF; r -= lf * I_LF; const int l = lf >> 1, f = lf & 1;
            bf16* slot = (bf16*)(ws + WS_WF + (size_t)lf * 17 * MiB);
            if (r < I_IN) { const float* W = a.in[f ? 24 : 11] + (size_t)l * D * 2 * FF; const int kb = r / 176, nb = r % 176;
                tr_item(W, 2 * FF, slot, D, 64 * kb, 32 * nb, swiglu_row(32 * nb), scr, lane); }
            else { r -= I_IN; const float* W = a.in[f ? 25 : 12] + (size_t)l * FF * D; const int kb = r / 32, nb = r % 32;
                tr_item(W, D, (bf16*)((unsigned char*)slot + 11 * MiB), FF, 64 * kb, 32 * nb, 32 * nb, scr, lane); }
            continue;
        }
        r -= I_FFN;
        if (r < I_EV) { const int kb = r / 64, nb = r % 64; tr_item(a.in[14], 2048, (bf16*)(ws + WS_WMI0), D, 64 * kb, 32 * nb, 32 * nb, scr, lane); continue; }
        r -= I_EV;
        if (r < I_OD) { const int kb = r / 96, nb = r % 96; tr_item(a.in[18], 3072, (bf16*)(ws + WS_WMI1), D, 64 * kb, 32 * nb, 32 * nb, scr, lane); continue; }
        r -= I_OD;
        if (r < I_MO0) { const int kb = r / 32, nb = r % 32; tr_item(a.in[22], D, (bf16*)(ws + WS_WMO0), D, 512 + 64 * kb, 32 * nb, 32 * nb, scr, lane); continue; }
        r -= I_MO0;
        { const int kb = r / 32, nb = r % 32; tr_item(a.in[22] + (size_t)D * D, D, (bf16*)(ws + WS_WMO1), D, 64 * kb, 32 * nb, 32 * nb, scr, lane); }
    }
    for (int it = gw; it < 4096; it += NGW) {
        const int arr = it >> 10, chunk = it & 1023;
        const float* src = a.in[2 + arr] + (size_t)chunk * 512 + lane * 8;
        const f32x4 v0 = *(const f32x4*)src, v1 = *(const f32x4*)(src + 4);
        u32x4 o; o.x = pk2(v0[0], v0[1]); o.y = pk2(v0[2], v0[3]); o.z = pk2(v1[0], v1[1]); o.w = pk2(v1[2], v1[3]);
        *(u32x4*)((bf16*)(ws + WS_CACHE + (size_t)arr * MiB) + (size_t)chunk * 512 + lane * 8) = o;
    }
    for (int it = gw; it < 1024; it += NGW) {
        const int k0 = (it >> 4) * 8, g = k0 >> 7, n = (it & 15) * 64 + lane;
        const float* pw = a.in[15] + (size_t)k0 * 128; const float* ps = a.in[16] + g * 128; const float* wo = a.in[22] + (size_t)(g * 128) * D + n;
        float acc[8];
#pragma unroll
        for (int i = 0; i < 8; ++i) acc[i] = 0.f;
        for (int dd = 0; dd < 128; ++dd) {
            const float w = wo[(size_t)dd * D] * ps[dd];
#pragma unroll
            for (int i = 0; i < 8; ++i) acc[i] += pw[i * 128 + dd] * w;
        }
        u32x4 o; o.x = pk2(acc[0], acc[1]); o.y = pk2(acc[2], acc[3]); o.z = pk2(acc[4], acc[5]); o.w = pk2(acc[6], acc[7]);
        *(u32x4*)((bf16*)(ws + WS_WMO0) + (size_t)n * D + k0) = o;
    }
    if (gw < 16) {
        const int idx = gw * 64 + lane, pos = idx >> 4, i = idx & 15;
        const double ang = (double)pos * ROPE_INV[i];
        const double kq = __builtin_rint(ang * 0.63661977236758134308);
        const double rr = (ang - kq * 1.57079632679489655800) - kq * 6.123233995736766e-17;
        const double r2 = rr * rr;
        double sp = 1.0 / 1307674368000.0 * -1.0;
        sp = sp * r2 + 1.0 / 6227020800.0; sp = sp * r2 - 1.0 / 39916800.0; sp = sp * r2 + 1.0 / 362880.0; sp = sp * r2 - 1.0 / 5040.0; sp = sp * r2 + 1.0 / 120.0; sp = sp * r2 - 1.0 / 6.0; sp = sp * r2 + 1.0;
        const double s = sp * rr;
        double cp = 1.0 / 20922789888000.0;
        cp = cp * r2 - 1.0 / 87178291200.0; cp = cp * r2 + 1.0 / 479001600.0; cp = cp * r2 - 1.0 / 3628800.0; cp = cp * r2 + 1.0 / 40320.0; cp = cp * r2 - 1.0 / 720.0; cp = cp * r2 + 1.0 / 24.0; cp = cp * r2 - 0.5; cp = cp * r2 + 1.0;
        const int q = ((int)kq) & 3;
        const double cv = (q == 0) ? cp : (q == 1) ? -s : (q == 2) ? -cp : s;
        const double sv = (q == 0) ? s : (q == 1) ? cp : (q == 2) ? -s : -cp;
        float* rope = (float*)(ws + WS_ROPE);
        rope[idx] = (float)cv; rope[1024 + idx] = (float)sv;
    }
}
__device__ __forceinline__ void p0_mods(const Args& a, LAS unsigned char* lds, int tid) {
    asm volatile("" : "+v"(tid));
    LAS float* sc = (LAS float*)lds;
    LAS float* red = (LAS float*)(lds + 12288);
    float* mods = (float*)(a.ws + WS_MODS);
    for (int u = blockIdx.x; u < 144; u += gridDim.x) {
        const int l = u / 72, n0 = (u % 72) * 128;
        for (int i = tid; i < 3072; i += NTHR) { const int c = i >> 10, k = i & 1023; const float v = (c == 0) ? a.in[7][k] : a.in[6][(c - 1) * D + k]; sc[i] = v / (1.0f + __expf(-v)); }
        __syncthreads();
        const int cgp = tid & 31, kg = tid >> 5;
        const float* wp = a.in[8] + ((size_t)l * D + kg * 64) * NMOD + n0 + cgp * 4;
        f32x4 a0 = {0.f, 0.f, 0.f, 0.f}, a1 = a0, a2 = a0;
#pragma unroll 4
        for (int k = 0; k < 64; ++k) { const f32x4 w = *(const f32x4*)(wp + (size_t)k * NMOD); const int kk = kg * 64 + k; a0 += w * sc[kk]; a1 += w * sc[1024 + kk]; a2 += w * sc[2048 + kk]; }
        *(LAS f32x4*)(red + (kg * 3 + 0) * 128 + cgp * 4) = a0; *(LAS f32x4*)(red + (kg * 3 + 1) * 128 + cgp * 4) = a1; *(LAS f32x4*)(red + (kg * 3 + 2) * 128 + cgp * 4) = a2;
        __syncthreads();
        if (tid < 384) { const int c = tid >> 7, n = tid & 127; float s = a.in[9][(size_t)l * NMOD + n0 + n];
#pragma unroll
            for (int kgi = 0; kgi < 16; ++kgi) s += red[(kgi * 3 + c) * 128 + n];
            mods[((size_t)l * 3 + c) * NMOD + n0 + n] = s; }
        __syncthreads();
    }
}

__device__ __forceinline__ void norm_phase(const float* bc, const float* bl, const float* g, const float* shift, const float* scale, bf16* H, int gw, int NGW, int lane) {
    asm volatile("" : "+v"(lane));
    for (int row = gw; row < M; row += NGW) {
        const float* xr = row < MCTX ? bc + (size_t)row * D : bl + (size_t)(row - MCTX) * D;
        const int co = cond_of_row(row) * NMOD;
        f32x4 v[4]; float ss = 0.f;
#pragma unroll
        for (int j = 0; j < 4; ++j) { v[j] = *(const f32x4*)(xr + 4 * (lane + 64 * j)); ss += (v[j][0] * v[j][0] + v[j][1] * v[j][1]) + (v[j][2] * v[j][2] + v[j][3] * v[j][3]); }
        const float rs = 1.0f / sqrtf(wave_sum(ss) * (1.0f / D) + EPS);
#pragma unroll
        for (int j = 0; j < 4; ++j) {
            const int col = 4 * (lane + 64 * j);
            const f32x4 gg = *(const f32x4*)(g + col), sc = *(const f32x4*)(scale + co + col), sh = *(const f32x4*)(shift + co + col);
            const f32x4 y = (v[j] * rs) * gg * (sc + 1.0f) + sh;
            u32x2 w; w.x = pk2(y[0], y[1]); w.y = pk2(y[2], y[3]);
            *(u32x2*)(H + (size_t)row * D + col) = w;
        }
    }
}
__device__ __forceinline__ void final_norm_phase(float* X, const float* g, int gw, int NGW, int lane) {
    asm volatile("" : "+v"(lane));
    for (int row = gw; row < M; row += NGW) {
        float* xr = X + (size_t)row * D;
        f32x4 v[4]; float ss = 0.f;
#pragma unroll
        for (int j = 0; j < 4; ++j) { v[j] = *(const f32x4*)(xr + 4 * (lane + 64 * j)); ss += (v[j][0] * v[j][0] + v[j][1] * v[j][1]) + (v[j][2] * v[j][2] + v[j][3] * v[j][3]); }
        const float rs = 1.0f / sqrtf(wave_sum(ss) * (1.0f / D) + EPS);
#pragma unroll
        for (int j = 0; j < 4; ++j) { const int col = 4 * (lane + 64 * j); *(f32x4*)(xr + col) = (v[j] * rs) * *(const f32x4*)(g + col); }
    }
}

__device__ __forceinline__ void unpack8(const u32x4 w, float (&f)[8]) { f[0] = bf_lo(w.x); f[1] = bf_hi(w.x); f[2] = bf_lo(w.y); f[3] = bf_hi(w.y); f[4] = bf_lo(w.z); f[5] = bf_hi(w.z); f[6] = bf_lo(w.w); f[7] = bf_hi(w.w); }
__device__ __forceinline__ void even_core_phase(const bf16* U, const float* conv_w, bf16* Y, int gtid, int NT) {
    asm volatile("" : "+v"(gtid));
    for (int idx = gtid; idx < M * 128; idx += NT) {
        const int row = idx >> 7, c8 = idx & 127;
        int n, t;
        if (row < MCTX) { n = 256; t = row & 255; } else { n = 4096; t = (row - MCTX) & 4095; }
        float o[8];
        if (c8 < 64) {
            const int half = 1 << (c8 >> 4);
            const int lo = (t - half) > 0 ? (t - half) : 0, hi = (t + half - 1) < (n - 1) ? (t + half - 1) : (n - 1);
            const bf16* up = U + (size_t)(row - t) * 2048 + c8 * 8;
            float s[8], x[8];
#pragma unroll
            for (int i = 0; i < 8; ++i) s[i] = 0.f;
            for (int tt = lo; tt <= hi; ++tt) { float f[8]; unpack8(*(const u32x4*)(up + (size_t)tt * 2048), f);
#pragma unroll
                for (int i = 0; i < 8; ++i) s[i] += f[i]; }
            unpack8(*(const u32x4*)(up + (size_t)t * 2048), x);
            const float inv = 1.0f / (float)(hi - lo + 1);
#pragma unroll
            for (int i = 0; i < 8; ++i) o[i] = s[i] * inv - x[i];
        } else {
            const int ch = (c8 - 64) * 8;
            const bf16* up = U + (size_t)row * 2048 + 512 + ch;
            float z[3][8], gb[8];
#pragma unroll
            for (int j = 0; j < 3; ++j) {
                const int tt = t + j - 1;
                if (tt >= 0 && tt < n) { float h[8], gc[8]; unpack8(*(const u32x4*)(up + (ptrdiff_t)(j - 1) * 2048), h); unpack8(*(const u32x4*)(up + (ptrdiff_t)(j - 1) * 2048 + 1024), gc);
#pragma unroll
                    for (int i = 0; i < 8; ++i) z[j][i] = gc[i] * h[i]; }
                else {
#pragma unroll
                    for (int i = 0; i < 8; ++i) z[j][i] = 0.f; }
            }
            unpack8(*(const u32x4*)(up + 512), gb);
            const f32x4 w0a = *(const f32x4*)(conv_w + ch), w0b = *(const f32x4*)(conv_w + ch + 4), w1a = *(const f32x4*)(conv_w + 512 + ch), w1b = *(const f32x4*)(conv_w + 512 + ch + 4),
                        w2a = *(const f32x4*)(conv_w + 1024 + ch), w2b = *(const f32x4*)(conv_w + 1024 + ch + 4);
#pragma unroll
            for (int i = 0; i < 4; ++i) { o[i] = gb[i] * (z[0][i] * w0a[i] + z[1][i] * w1a[i] + z[2][i] * w2a[i]); o[4 + i] = gb[4 + i] * (z[0][4 + i] * w0b[i] + z[1][4 + i] * w1b[i] + z[2][4 + i] * w2b[i]); }
        }
        u32x4 w; w.x = pk2(o[0], o[1]); w.y = pk2(o[2], o[3]); w.z = pk2(o[4], o[5]); w.w = pk2(o[6], o[7]);
        *(u32x4*)(Y + (size_t)row * D + c8 * 8) = w;
    }
}

constexpr int AT_KS = 144, AT_KBYTES = 2 * 64 * AT_KS;
constexpr int AT_VBYTES = 24576, AT_STAGE = AT_KBYTES + AT_VBYTES;
constexpr int AT_RPB = 2 * AT_STAGE;
struct AttnUnit {
    const bf16* Q; int ldq;
    int qcol0, qcol1;
    const bf16 *K00, *K01, *K10, *K11, *V00, *V01, *V10, *V11; int ld0, ld1, nt0, nt1;
    bf16* Y; int ycol0, ycol1;
    int rq0, krlo;
    const float* rpb;
};
__device__ __forceinline__ s16x4 tr_read(const LAS unsigned char* p) { return __builtin_amdgcn_ds_read_tr16_b64_v4i16((LAS s16x4*)p); }

template <int DV, int MODE>
__device__ __forceinline__ void attn_unit(LAS unsigned char* lds, const AttnUnit& A, float lam, const float* dnorm, int tid) {
    asm volatile("" : "+v"(tid));
    const int lane = tid & 63, wave = __builtin_amdgcn_readfirstlane(tid >> 6), s = wave >> 2, wq = wave & 3, ql = lane & 31, h = lane >> 5;
    constexpr int NEB = DV / 32, VS = (DV == 64) ? 192 : 320;
    const int kr_ = (tid >> 3) & 63, kc_ = tid & 7;
    const int vr_ = (DV == 64) ? kr_ : (tid >> 4), vc_ = (DV == 64) ? kc_ : (tid & 15);
    const unsigned k_lds0 = 0 * 64 * AT_KS + kr_ * AT_KS + kc_ * 16, k_lds1 = 64 * AT_KS + kr_ * AT_KS + kc_ * 16;
    const unsigned v_lds0 = AT_KBYTES + vr_ * VS + vc_ * 16, v_lds1 = AT_KBYTES + ((DV == 64) ? (64 * 192 + vr_ * VS + vc_ * 16) : ((vr_ + 32) * VS + vc_ * 16));
    u32x4 kreg0, kreg1, vreg0, vreg1;
    const int nt0 = A.nt0, ntot = A.nt0 + A.nt1;
#define AT_LOAD(t) do { const bool sg_ = (t) >= nt0; const int tt_ = (t) - (sg_ ? nt0 : 0); const int ld_ = sg_ ? A.ld1 : A.ld0; const size_t ro_ = (size_t)(tt_ * 64) * ld_; \
        const bf16* k0_ = sg_ ? A.K10 : A.K00; const bf16* k1_ = sg_ ? A.K11 : A.K01; const bf16* v0_ = sg_ ? A.V10 : A.V00; const bf16* v1_ = sg_ ? A.V11 : A.V01; \
        kreg0 = *(const u32x4*)(k0_ + ro_ + (size_t)kr_ * ld_ + kc_ * 8); kreg1 = *(const u32x4*)(k1_ + ro_ + (size_t)kr_ * ld_ + kc_ * 8); \
        if (DV == 64) { vreg0 = *(const u32x4*)(v0_ + ro_ + (size_t)vr_ * ld_ + vc_ * 8); vreg1 = *(const u32x4*)(v1_ + ro_ + (size_t)vr_ * ld_ + vc_ * 8); } \
        else { vreg0 = *(const u32x4*)(v0_ + ro_ + (size_t)vr_ * ld_ + vc_ * 8); vreg1 = *(const u32x4*)(v0_ + ro_ + (size_t)(vr_ + 32) * ld_ + vc_ * 8); } } while (0)
#define AT_STORE(b) do { LAS unsigned char* sb_ = lds + (b) * AT_STAGE; *(LAS u32x4*)(sb_ + k_lds0) = kreg0; *(LAS u32x4*)(sb_ + k_lds1) = kreg1; *(LAS u32x4*)(sb_ + v_lds0) = vreg0; *(LAS u32x4*)(sb_ + v_lds1) = vreg1; } while (0)
    const int qrow = 32 * wq + ql;
    bf16x8 qf[4];
#pragma unroll
    for (int ds = 0; ds < 4; ++ds) qf[ds] = *(const bf16x8*)(A.Q + (size_t)qrow * A.ldq + (s ? A.qcol1 : A.qcol0) + 16 * ds + 8 * h);
    int rq = 0, r0q = 0, cq = 0, c0 = 0;
    LAS float* rpbs = (LAS float*)(lds + AT_RPB);
    if (MODE == 1) {
        rq = A.rq0 + (wq >> 1); r0q = rq - 4; r0q = r0q < 0 ? 0 : (r0q > 56 ? 56 : r0q);
        cq = 32 * (wq & 1) + ql; c0 = cq - 8; c0 = c0 < 0 ? 0 : (c0 > 48 ? 48 : c0);
        for (int i = tid; i < 930; i += NTHR) rpbs[i] = A.rpb[i] * LOG2E;
    }
    f32x16 o[NEB];
#pragma unroll
    for (int eb = 0; eb < NEB; ++eb)
#pragma unroll
        for (int r = 0; r < 16; ++r) o[eb][r] = 0.f;
    float mrun = -1e30f, lrun = 0.f;
    const LAS unsigned char* kbase = lds + s * 64 * AT_KS + ql * AT_KS + 16 * h;
    const LAS unsigned char* vbase = lds + AT_KBYTES + ((DV == 64) ? s * 64 * 192 : 0) + (4 * h + ((lane & 15) >> 2)) * VS + (16 * ((lane >> 4) & 1) + 4 * (lane & 3)) * 2;

    AT_LOAD(0); AT_STORE(0);
    __syncthreads();
    for (int t = 0; t < ntot; ++t) {
        const int buf = t & 1;
        if (t + 1 < ntot) AT_LOAD(t + 1);
        bool vis = true; int kr = 0;
        if (MODE == 1 && t >= nt0) { kr = A.krlo + (t - nt0); vis = (kr >= r0q) && (kr < r0q + 8); }
        if (vis) {
            const LAS unsigned char* kb = kbase + buf * AT_STAGE;
            f32x16 p0, p1;
#pragma unroll
            for (int r = 0; r < 16; ++r) { p0[r] = 0.f; p1[r] = 0.f; }
#pragma unroll
            for (int ds = 0; ds < 4; ++ds) {
                const bf16x8 a0 = *(const LAS bf16x8*)(kb + 32 * ds), a1 = *(const LAS bf16x8*)(kb + 32 * AT_KS + 32 * ds);
                p0 = __builtin_amdgcn_mfma_f32_32x32x16_bf16(a0, qf[ds], p0, 0, 0, 0);
                p1 = __builtin_amdgcn_mfma_f32_32x32x16_bf16(a1, qf[ds], p1, 0, 0, 0);
            }
            if (MODE == 1 && t >= nt0) {
                const LAS float* bp = rpbs + s * 465 + (kr - rq + 7) * 31 + 15 - cq;
#pragma unroll
                for (int r = 0; r < 16; ++r) {
                    const int kc0 = (r & 3) + 8 * (r >> 2) + 4 * h, kc1 = kc0 + 32;
                    p0[r] = (kc0 >= c0 && kc0 < c0 + 16) ? p0[r] + bp[kc0] : -1e30f;
                    p1[r] = (kc1 >= c0 && kc1 < c0 + 16) ? p1[r] + bp[kc1] : -1e30f;
                }
            }
            float mt = fmaxf(p0[0], p1[0]);
#pragma unroll
            for (int r = 1; r < 16; ++r) mt = fmaxf(mt, fmaxf(p0[r], p1[r]));
            mt = fmaxf(mt, __shfl_xor(mt, 32));
            const float mnew = fmaxf(mrun, mt), alpha = fast_exp2(mrun - mnew);
            mrun = mnew;
            float ps = 0.f;
#pragma unroll
            for (int r = 0; r < 16; ++r) { p0[r] = fast_exp2(p0[r] - mnew); p1[r] = fast_exp2(p1[r] - mnew); ps += p0[r] + p1[r]; }
            lrun = lrun * alpha + ps;
            bf16x8 pb[2][2];
#pragma unroll
            for (int s2 = 0; s2 < 2; ++s2) {
                u32x4 w0, w1;
                w0.x = pk2(p0[8 * s2 + 0], p0[8 * s2 + 1]); w0.y = pk2(p0[8 * s2 + 2], p0[8 * s2 + 3]); w0.z = pk2(p0[8 * s2 + 4], p0[8 * s2 + 5]); w0.w = pk2(p0[8 * s2 + 6], p0[8 * s2 + 7]);
                w1.x = pk2(p1[8 * s2 + 0], p1[8 * s2 + 1]); w1.y = pk2(p1[8 * s2 + 2], p1[8 * s2 + 3]); w1.z = pk2(p1[8 * s2 + 4], p1[8 * s2 + 5]); w1.w = pk2(p1[8 * s2 + 6], p1[8 * s2 + 7]);
                pb[0][s2] = __builtin_bit_cast(bf16x8, w0); pb[1][s2] = __builtin_bit_cast(bf16x8, w1);
            }
            const LAS unsigned char* vb = vbase + buf * AT_STAGE;
#pragma unroll
            for (int eb = 0; eb < NEB; ++eb) {
                __builtin_amdgcn_sched_barrier(0);
#pragma unroll
                for (int r = 0; r < 16; ++r) o[eb][r] *= alpha;
#pragma unroll
                for (int kbk = 0; kbk < 2; ++kbk)
#pragma unroll
                    for (int s2 = 0; s2 < 2; ++s2) {
                        const s16x4 lo = tr_read(vb + (kbk * 32 + 16 * s2) * VS + eb * 64), hi = tr_read(vb + (kbk * 32 + 16 * s2 + 8) * VS + eb * 64);
                        const bf16x8 av = {lo[0], lo[1], lo[2], lo[3], hi[0], hi[1], hi[2], hi[3]};
                        o[eb] = __builtin_amdgcn_mfma_f32_32x32x16_bf16(av, pb[kbk][s2], o[eb], 0, 0, 0);
                    }
            }
        }
        if (t + 1 < ntot) AT_STORE(buf ^ 1);
        __syncthreads();
    }
#undef AT_LOAD
#undef AT_STORE
    const float ltot = lrun + __shfl_xor(lrun, 32), linv = 1.0f / ltot;
    if (DV == 64) {
        bf16* yp = A.Y + (size_t)qrow * D + (s ? A.ycol1 : A.ycol0) + 4 * h;
#pragma unroll
        for (int eb = 0; eb < NEB; ++eb)
#pragma unroll
            for (int r4 = 0; r4 < 4; ++r4) { u32x2 w; w.x = pk2(o[eb][4 * r4] * linv, o[eb][4 * r4 + 1] * linv); w.y = pk2(o[eb][4 * r4 + 2] * linv, o[eb][4 * r4 + 3] * linv);
                *(u32x2*)(yp + eb * 32 + 8 * r4) = w; }
    } else {
        LAS float* xs = (LAS float*)lds + (size_t)wq * (NEB * 16 * 64) + lane;
        if (s == 1) { const float f = lam * linv;
#pragma unroll
            for (int eb = 0; eb < NEB; ++eb)
#pragma unroll
                for (int r = 0; r < 16; ++r) xs[(eb * 16 + r) * 64] = o[eb][r] * f; }
        __syncthreads();
        if (s == 0) {
            float ss = 0.f;
#pragma unroll
            for (int eb = 0; eb < NEB; ++eb)
#pragma unroll
                for (int r = 0; r < 16; ++r) { const float v = o[eb][r] * linv - xs[(eb * 16 + r) * 64]; o[eb][r] = v; ss += v * v; }
            ss += __shfl_xor(ss, 32);
            const float rs = (1.0f / sqrtf(ss * (1.0f / 128.0f) + EPS)) * (1.0f - LAM_INIT);
            bf16* yp = A.Y + (size_t)qrow * D + A.ycol0 + 4 * h;
#pragma unroll
            for (int eb = 0; eb < NEB; ++eb)
#pragma unroll
                for (int r4 = 0; r4 < 4; ++r4) { const f32x4 g = *(const f32x4*)(dnorm + eb * 32 + 8 * r4 + 4 * h);
                    u32x2 w; w.x = pk2(o[eb][4 * r4] * rs * g[0], o[eb][4 * r4 + 1] * rs * g[1]); w.y = pk2(o[eb][4 * r4 + 2] * rs * g[2], o[eb][4 * r4 + 3] * rs * g[3]);
                    *(u32x2*)(yp + eb * 32 + 8 * r4) = w; }
        }
        __syncthreads();
    }
}

__device__ __forceinline__ void attn_phase(const Args& a, LAS unsigned char* lds, int vcu, int G, int tid) {
    unsigned char* ws = a.ws;
    const bf16* U = (const bf16*)(ws + WS_ACT); bf16* Y = (bf16*)(ws + WS_Y);
    const bf16* CNK = (const bf16*)(ws + WS_CACHE), *CNV = (const bf16*)(ws + WS_CACHE + MiB), *CDK = (const bf16*)(ws + WS_CACHE + 2 * MiB), *CDV = (const bf16*)(ws + WS_CACHE + 3 * MiB);
    const int lane = tid & 63;
    const float* lp = a.in[20];
    const float lam = __expf(wave_sum(lp[lane] * lp[64 + lane])) - __expf(wave_sum(lp[128 + lane] * lp[192 + lane])) + LAM_INIT;
    const float* dnorm = a.in[21];
    for (int u = vcu; u < 256; u += G) {
        const int b = u >> 7, hh = (u >> 5) & 3, qt = u & 31;
        const size_t r0 = (size_t)MCTX + (size_t)b * 4096;
        AttnUnit A;
        A.Q = U + (r0 + qt * 128) * 3072; A.ldq = 3072; A.qcol0 = 1536 + hh * 128; A.qcol1 = A.qcol0 + 64;
        A.K00 = U + r0 * 3072 + 2048 + hh * 128; A.K01 = A.K00 + 64; A.V00 = U + r0 * 3072 + 2560 + hh * 128; A.V01 = A.V00; A.ld0 = 3072; A.nt0 = 64;
        A.K10 = CDK + (size_t)b * 512 * 512 + hh * 128; A.K11 = A.K10 + 64; A.V10 = CDV + (size_t)b * 512 * 512 + hh * 128; A.V11 = A.V10; A.ld1 = 512; A.nt1 = 8;
        A.Y = Y + (r0 + qt * 128) * D; A.ycol0 = 512 + hh * 128; A.ycol1 = A.ycol0;
        A.rq0 = 0; A.krlo = 0; A.rpb = nullptr;
        attn_unit<128, 0>(lds, A, lam, dnorm, tid);
    }
    for (int u = vcu; u < 256; u += G) {
        const int b = u >> 7, hp = (u >> 5) & 3, rp = u & 31;
        const size_t r0 = (size_t)MCTX + (size_t)b * 4096;
        int klo = 2 * rp - 4; klo = klo < 0 ? 0 : (klo > 56 ? 56 : klo);
        int khi = 2 * rp + 1 - 4; khi = khi < 0 ? 0 : (khi > 56 ? 56 : khi);
        AttnUnit A;
        A.Q = U + (r0 + rp * 128) * 3072; A.ldq = 3072; A.qcol0 = hp * 128; A.qcol1 = A.qcol0 + 64;
        A.K00 = CNK + (size_t)b * 512 * 512 + hp * 128; A.K01 = A.K00 + 64; A.V00 = CNV + (size_t)b * 512 * 512 + hp * 128; A.V01 = A.V00 + 64; A.ld0 = 512; A.nt0 = 8;
        A.K10 = U + (r0 + klo * 64) * 3072 + 512 + hp * 128; A.K11 = A.K10 + 64; A.V10 = U + (r0 + klo * 64) * 3072 + 1024 + hp * 128; A.V11 = A.V10 + 64; A.ld1 = 3072; A.nt1 = khi + 8 - klo;
        A.Y = Y + (r0 + rp * 128) * D; A.ycol0 = hp * 128; A.ycol1 = A.ycol0 + 64;
        A.rq0 = 2 * rp; A.krlo = klo; A.rpb = a.in[19] + (size_t)(2 * hp) * 465;
        attn_unit<64, 1>(lds, A, lam, dnorm, tid);
    }
    for (int u = vcu; u < 256; u += G) {
        const int b = u >> 3, hh = (u >> 1) & 3, qt = u & 1;
        const size_t r0 = (size_t)b * 256;
        AttnUnit A;
        A.Q = U + (r0 + qt * 128) * 3072; A.ldq = 3072; A.qcol0 = 1536 + hh * 128; A.qcol1 = A.qcol0 + 64;
        A.K00 = U + r0 * 3072 + 2048 + hh * 128; A.K01 = A.K00 + 64; A.V00 = U + r0 * 3072 + 2560 + hh * 128; A.V01 = A.V00; A.ld0 = 3072; A.nt0 = 4;
        A.K10 = A.K00; A.K11 = A.K01; A.V10 = A.V00; A.V11 = A.V01; A.ld1 = 3072; A.nt1 = 0;
        A.Y = Y + (r0 + qt * 128) * D; A.ycol0 = 512 + hh * 128; A.ycol1 = A.ycol0;
        A.rq0 = 0; A.krlo = 0; A.rpb = nullptr;
        attn_unit<128, 0>(lds, A, lam, dnorm, tid);
    }
    for (int u = vcu; u < 256; u += G) {
        const int b = u >> 3, hp = (u >> 1) & 3, qt = u & 1;
        const size_t r0 = (size_t)b * 256;
        AttnUnit A;
        A.Q = U + (r0 + qt * 128) * 3072; A.ldq = 3072; A.qcol0 = hp * 128; A.qcol1 = A.qcol0 + 64;
        A.K00 = U + r0 * 3072 + 512 + hp * 128; A.K01 = A.K00 + 64; A.V00 = U + r0 * 3072 + 1024 + hp * 128; A.V01 = A.V00 + 64; A.ld0 = 3072; A.nt0 = 4;
        A.K10 = A.K00; A.K11 = A.K01; A.V10 = A.V00; A.V11 = A.V01; A.ld1 = 3072; A.nt1 = 0;
        A.Y = Y + (r0 + qt * 128) * D; A.ycol0 = hp * 128; A.ycol1 = A.ycol0 + 64;
        A.rq0 = 0; A.krlo = 0; A.rpb = nullptr;
        attn_unit<64, 0>(lds, A, lam, dnorm, tid);
    }
}

__global__ void __launch_bounds__(NTHR, 2) hybrid_fwd(Args a) {
    extern __shared__ __attribute__((aligned(16))) unsigned char lds_raw[];
    LAS unsigned char* lds = (LAS unsigned char*)lds_raw;
    cg::grid_group grid = cg::this_grid();
    const int tid = threadIdx.x, lane = tid & 63, wave = __builtin_amdgcn_readfirstlane(tid >> 6);
    const int G = gridDim.x, bx = blockIdx.x;
    const int vcu = (G % 8 == 0) ? (bx % 8) * (G / 8) + bx / 8 : bx;
    const int gw = vcu * NWAVES + wave, NGW = G * NWAVES;
    unsigned char* ws = a.ws;
    float* X = a.out;
    float* mods = (float*)(ws + WS_MODS);
    bf16* H = (bf16*)(ws + WS_H); bf16* Y = (bf16*)(ws + WS_Y); bf16* ACT = (bf16*)(ws + WS_ACT);

#ifndef NO_P0
    p0_mods(a, lds, tid);
    p0_weights(a, lds, gw, NGW, wave, lane);
#endif
    grid.sync();

#pragma unroll
    for (int l = 0; l < 2; ++l) {
        const float* ml = mods + (size_t)l * 3 * NMOD;
#pragma unroll
        for (int part = 0; part < 3; ++part) {
            const bool first = (l == 0 && part == 0);
            const float* bc = first ? a.in[0] : X; const float* bl = first ? a.in[1] : X + (size_t)MCTX * D;
            if (part != 1) {
                const int f = part >> 1;
                const float* g = a.in[f ? 23 : 10] + (size_t)l * D;
                norm_phase(bc, bl, g, ml + (f ? 6 : 0) * D, ml + (f ? 7 : 1) * D, H, gw, NGW, lane);
                grid.sync();
                const bf16* Win = (const bf16*)(ws + WS_WF + (size_t)(l * 2 + f) * 17 * MiB); const bf16* Wout = (const bf16*)((const unsigned char*)Win + 11 * MiB);
#ifndef NO_SWG
                { EpiSwiglu E{ACT}; run_gemm(lds, H, Win, 2 * FF, D, E); }
#endif
                grid.sync();
#ifndef NO_RES1
                { EpiResid E{bc, bl, X, ml + (f ? 8 : 2) * D, 0.5f}; run_gemm(lds, ACT, Wout, D, FF, E); }
#endif
                grid.sync();
            } else {
                norm_phase(bc, bl, a.in[13] + (size_t)l * D, ml + 3 * D, ml + 4 * D, H, gw, NGW, lane);
                grid.sync();
                if (l == 0) {
#ifndef NO_EVG
                    { EpiBf16P E{ACT, 2048}; run_gemm(lds, H, (const bf16*)(ws + WS_WMI0), 2048, D, E); }
#endif
                    grid.sync();
#ifndef NO_EVEN
                    even_core_phase(ACT, a.in[17], Y, vcu * NTHR + tid, G * NTHR);
#endif
                } else {
#ifndef NO_ODDG
                    { EpiOdd E{ACT, a.out + (size_t)M * D, (const float*)(ws + WS_ROPE)}; run_gemm(lds, H, (const bf16*)(ws + WS_WMI1), 3072, D, E); }
#endif
                    grid.sync();
#ifndef NO_ATTN
                    attn_phase(a, lds, vcu, G, tid);
#endif
                }
                grid.sync();
#ifndef NO_RES2
                { EpiResid E{bc, bl, X, ml + 5 * D, 1.0f}; run_gemm(lds, Y, (const bf16*)(ws + (l == 0 ? WS_WMO0 : WS_WMO1)), D, D, E); }
#endif
                grid.sync();
            }
        }
    }
    final_norm_phase(X, a.in[26], gw, NGW, lane);
}

extern "C" void kernel_launch(void* const* d_in, const int* in_sizes, int n_in, void* d_out, int out_size, void* d_ws, size_t ws_size, hipStream_t stream) {
    static int grid = 0;
    if (grid == 0) {
        if (n_in != 27 || ws_size < WS_END) { fprintf(stderr, "kernel_launch: unexpected n_in %d / ws_size %zu\n", n_in, ws_size); grid = -1; return; }
        int dev = 0, cus = 0, per_cu = 0;
        (void)hipGetDevice(&dev); (void)hipDeviceGetAttribute(&cus, hipDeviceAttributeMultiprocessorCount, dev);
        if (hipFuncSetAttribute((const void*)hybrid_fwd, hipFuncAttributeMaxDynamicSharedMemorySize, LDS_BYTES) != hipSuccess) { fprintf(stderr, "kernel_launch: hipFuncSetAttribute failed\n"); grid = -1; return; }
        if (hipOccupancyMaxActiveBlocksPerMultiprocessor(&per_cu, (const void*)hybrid_fwd, NTHR, LDS_BYTES) != hipSuccess || per_cu < 1) { fprintf(stderr, "kernel_launch: occupancy query says %d\n", per_cu); per_cu = 1; }
        (void)hipGetLastError();
        grid = cus * per_cu;
        fprintf(stderr, "kernel_launch: grid %d (cus %d x %d)\n", grid, cus, per_cu);
    }
    if (grid < 0) return;
    Args a{};
    for (int i = 0; i < 27; ++i) a.in[i] = (const float*)d_in[i];
    a.out = (float*)d_out; a.ws = (unsigned char*)d_ws;
    void* kargs[] = {&a};
    hipError_t e = hipLaunchCooperativeKernel((const void*)hybrid_fwd, dim3(grid), dim3(NTHR), kargs, LDS_BYTES, stream);
    if (e != hipSuccess) fprintf(stderr, "kernel_launch: cooperative launch failed: %s (grid %d)\n", hipGetErrorString(e), grid);
}
```

```cpp
#include <hip/hip_runtime.h>
#include <hip/hip_cooperative_groups.h>
#include <cstdio>
#include <cstdint>
namespace cg = cooperative_groups;
namespace pg8 {
#define PG8_LAS __attribute__((address_space(3)))
typedef unsigned short bf16_t;
typedef short bf16x8 __attribute__((ext_vector_type(8)));
typedef float f32x4 __attribute__((ext_vector_type(4)));
typedef unsigned u32x4 __attribute__((ext_vector_type(4)));
constexpr int BM = 256, BK = 64, HALF = 128, HTB = HALF * BK * 2  , STAGE_BYTES = 8 * HTB, NXCD = 8, WGM = 8;

__host__ __device__ __forceinline__ int lds_byte(int r, int c) { const int st = (r >> 4) * 2 + (c >> 5), rr = r & 15, cc = c & 31, ob = rr * 64 + cc * 2; return st * 1024 + (ob ^ (((ob >> 9) & 1) << 5)); }
__host__ __device__ __forceinline__ void stage_rc(int b, int& R, int& C) { const int st = b / 1024, sb = b % 1024, swz = sb ^ (((sb >> 9) & 1) << 5); R = (st >> 1) * 16 + swz / 64; C = (st & 1) * 32 + (swz % 64) / 2; }
__host__ __device__ __forceinline__ int perm32(int rho) { const int n = rho >> 4, i = rho & 15; return 8 * (i >> 2) + 4 * n + (i & 3); }

struct Unit { int pm, pn; };
struct Gemm { const bf16_t* A; const bf16_t* Bt; int M, N, K; };

struct StaticOrder {
    int nM, nN, nwg, G, c;
    __host__ __device__ void init(int M, int N, int G_, int c_) { nM = M / BM; nN = N / BM; nwg = nM * nN; G = G_; c = c_; }
    __host__ __device__ bool next(int i, Unit& u) const {
        const long L = (long)i * G + c; if (L >= nwg) return false;
        int wgid = (int)L; { const int q = nwg / NXCD, r = nwg % NXCD, xcd = wgid % NXCD, off = wgid / NXCD; wgid = (xcd < r ? xcd * (q + 1) : r * (q + 1) + (xcd - r) * q) + off; }
        const int nig = WGM * nN, gid = wgid / nig, fm = gid * WGM, gsz = (nM - fm) < WGM ? (nM - fm) : WGM;
        u.pm = fm + ((wgid % nig) % gsz); u.pn = (wgid % nig) / gsz; return true;
    }
    __device__ __forceinline__ void a_ready(const Unit&) const {}
    __device__ __forceinline__ void done(const Unit&) const {}
};
__device__ __forceinline__ unsigned cvt_pk_bf16(float lo, float hi) { unsigned r; asm volatile("v_cvt_pk_bf16_f32 %0, %1, %2" : "=v"(r) : "v"(lo), "v"(hi)); return r; }
template <class Epi, class Sched, bool ALIGN_EPI = false, bool SP2 = false>
__device__ __forceinline__ void gemm_phase(PG8_LAS unsigned char* lds, const Gemm g, const Sched& S, const Epi& E) {
    int tid_ = threadIdx.x; asm volatile("" : "+v"(tid_));
    const int tid = tid_, wid = __builtin_amdgcn_readfirstlane(tid >> 6), lane = tid & 63, wr = wid >> 2, wc = wid & 3, fr = lane & 15, fq = lane >> 4;
    const int K = g.K, nt = K / BK;
    unsigned voffA[2], voffB[2];
#pragma unroll
    for (int i = 0; i < 2; ++i) { int R, C; stage_rc(tid * 16 + i * 8192, R, C); const int Rb = Epi::PERM ? ((R & ~31) + perm32(R & 31)) : R;
        voffA[i] = (unsigned)(R * K + C) * 2u; voffB[i] = (unsigned)(Rb * K + C) * 2u; }
    const size_t kstep = (size_t)(BK * 2);
    const size_t hstep = (size_t)HALF * K * 2;
    const size_t tstep = 2 * hstep;
    const unsigned ldsw = (unsigned)wid * 1024u;
    const int aoff = lds_byte(wr * 64 + fr, fq * 8), boff = lds_byte(wc * 32 + fr, fq * 8);
#define PG8_SA(b, h) (((b) * 2 + (h)) * HTB)
#define PG8_SB(b, h) ((4 + (b) * 2 + (h)) * HTB)
#define PG8_STAGE(bufoff, gbase, voff) do { _Pragma("unroll") for (int _i = 0; _i < 2; ++_i) \
        __builtin_amdgcn_global_load_lds((const unsigned*)((const char*)(gbase) + (voff)[_i]), (PG8_LAS unsigned*)(lds + (bufoff) + ldsw + _i * 8192), 16, 0, 0); } while (0)
#define PG8_LDA(dst, b, h) do { _Pragma("unroll") for (int m = 0; m < 4; ++m) _Pragma("unroll") for (int k = 0; k < 2; ++k) dst[m][k] = *(const PG8_LAS bf16x8*)(lds + PG8_SA(b, h) + aoff + m * 2048 + k * 1024); } while (0)
#define PG8_LDB(dst, b, h) do { _Pragma("unroll") for (int n = 0; n < 2; ++n) _Pragma("unroll") for (int k = 0; k < 2; ++k) dst[n][k] = *(const PG8_LAS bf16x8*)(lds + PG8_SB(b, h) + boff + n * 2048 + k * 1024); } while (0)
#define PG8_MMA(ai, bj, At, Bt) do { __builtin_amdgcn_s_setprio(1); _Pragma("unroll") for (int m = 0; m < 4; ++m) _Pragma("unroll") for (int n = 0; n < 2; ++n) _Pragma("unroll") for (int k = 0; k < 2; ++k) \
        acc[ai][bj][m][n] = __builtin_amdgcn_mfma_f32_16x16x32_bf16(Bt[n][k], At[m][k], acc[ai][bj][m][n], 0, 0, 0); __builtin_amdgcn_s_setprio(0); } while (0)
#define PG8_WAIT_V(n) asm volatile("s_waitcnt vmcnt(" #n ")" ::: "memory")
#define PG8_WAIT_L(n) asm volatile("s_waitcnt lgkmcnt(" #n ")" ::: "memory")
#define PG8_BAR __builtin_amdgcn_s_barrier()
#define PG8_SCHED __builtin_amdgcn_sched_barrier(0)
    Unit cur, nxt; int ui = 0;
    if (!S.next(0, cur)) return;
    f32x4 acc[2][2][4][2];
#pragma unroll
    for (int a = 0; a < 2; ++a)
#pragma unroll
        for (int b = 0; b < 2; ++b)
#pragma unroll
            for (int m = 0; m < 4; ++m)
#pragma unroll
                for (int n = 0; n < 2; ++n) acc[a][b][m][n] = (f32x4){0.f, 0.f, 0.f, 0.f};
    bf16x8 At[4][2], B0[2][2], B1[2][2];
    const char* cA = (const char*)g.A + (size_t)cur.pm * tstep; const char* cB = (const char*)g.Bt + (size_t)cur.pn * tstep;
    S.a_ready(cur);
    if constexpr (SP2) {
        PG8_STAGE(PG8_SB(0, 0), cB, voffB); PG8_STAGE(PG8_SB(0, 1), cB + hstep, voffB); PG8_STAGE(PG8_SA(0, 0), cA, voffA); PG8_STAGE(PG8_SA(0, 1), cA + hstep, voffA);
        if (wr == 1) PG8_BAR;
        PG8_WAIT_V(2); PG8_BAR;
        PG8_STAGE(PG8_SB(1, 0), cB + kstep, voffB); PG8_STAGE(PG8_SA(1, 0), cA + kstep, voffA); PG8_STAGE(PG8_SB(1, 1), cB + hstep + kstep, voffB);
        PG8_WAIT_V(6); PG8_BAR;
    } else {
        PG8_STAGE(PG8_SB(0, 0), cB, voffB); PG8_STAGE(PG8_SA(0, 0), cA, voffA); PG8_STAGE(PG8_SB(0, 1), cB + hstep, voffB); PG8_STAGE(PG8_SA(0, 1), cA + hstep, voffA);
        if (wr == 1) PG8_BAR;
        PG8_WAIT_V(4); PG8_BAR;
        PG8_STAGE(PG8_SB(1, 0), cB + kstep, voffB); PG8_STAGE(PG8_SA(1, 0), cA + kstep, voffA); PG8_STAGE(PG8_SB(1, 1), cB + hstep + kstep, voffB);
        PG8_WAIT_V(6); PG8_BAR;
    }
    for (;;) {
        const bool has_next = S.next(ui + 1, nxt);
        const char* nA = has_next ? (const char*)g.A + (size_t)nxt.pm * tstep : cA; const char* nB = has_next ? (const char*)g.Bt + (size_t)nxt.pn * tstep : cB;
        for (int t = 0; t < nt; t += 2) {
            const bool last = (t == nt - 2);
            const char* a1 = cA + (size_t)(t + 1) * kstep;
            const char* a2 = last ? nA : cA + (size_t)(t + 2) * kstep; const char* b2 = last ? nB : cB + (size_t)(t + 2) * kstep;
            const char* a3 = a2 + kstep; const char* b3 = b2 + kstep;
            if (last && has_next) S.a_ready(nxt);
            if constexpr (SP2) {
            PG8_LDB(B0, 0, 0); PG8_LDB(B1, 0, 1); PG8_SCHED; PG8_LDA(At, 0, 0); PG8_STAGE(PG8_SA(1, 1), a1 + hstep, voffA);
            PG8_WAIT_V(8); PG8_WAIT_L(0); PG8_BAR; PG8_MMA(0, 0, At, B0); PG8_MMA(0, 1, At, B1); PG8_BAR; PG8_SCHED;
            PG8_LDA(At, 0, 1); PG8_STAGE(PG8_SB(0, 0), b2, voffB); PG8_STAGE(PG8_SB(0, 1), b2 + hstep, voffB); PG8_STAGE(PG8_SA(0, 0), a2, voffA);
            PG8_WAIT_V(8); PG8_WAIT_L(0); PG8_BAR; PG8_MMA(1, 0, At, B0); PG8_MMA(1, 1, At, B1); PG8_BAR; PG8_SCHED;
            PG8_LDB(B0, 1, 0); PG8_LDB(B1, 1, 1); PG8_SCHED; PG8_LDA(At, 1, 0); PG8_STAGE(PG8_SA(0, 1), a2 + hstep, voffA);
            PG8_WAIT_V(8); PG8_WAIT_L(0); PG8_BAR; PG8_MMA(0, 0, At, B0); PG8_MMA(0, 1, At, B1); PG8_BAR; PG8_SCHED;
            PG8_LDA(At, 1, 1); PG8_STAGE(PG8_SB(1, 0), b3, voffB); PG8_STAGE(PG8_SB(1, 1), b3 + hstep, voffB); PG8_STAGE(PG8_SA(1, 0), a3, voffA);
            PG8_WAIT_V(8); PG8_WAIT_L(0); PG8_BAR; PG8_MMA(1, 0, At, B0); PG8_MMA(1, 1, At, B1); PG8_BAR; PG8_SCHED;
            } else {
            PG8_LDB(B0, 0, 0); PG8_SCHED; PG8_LDA(At, 0, 0); PG8_STAGE(PG8_SA(1, 1), a1 + hstep, voffA);
            PG8_WAIT_L(8); PG8_BAR; PG8_WAIT_L(0); PG8_MMA(0, 0, At, B0); PG8_BAR; PG8_SCHED;
            PG8_LDB(B1, 0, 1); PG8_STAGE(PG8_SB(0, 0), b2, voffB);
            PG8_BAR; PG8_WAIT_L(0); PG8_MMA(0, 1, At, B1); PG8_BAR;
            PG8_LDA(At, 0, 1); PG8_STAGE(PG8_SA(0, 0), a2, voffA);
            PG8_BAR; PG8_WAIT_L(0); PG8_MMA(1, 0, At, B0); PG8_BAR; PG8_SCHED;
            PG8_STAGE(PG8_SB(0, 1), b2 + hstep, voffB);
            PG8_WAIT_V(6); PG8_BAR; PG8_MMA(1, 1, At, B1); PG8_BAR;
            PG8_LDB(B0, 1, 0); PG8_SCHED; PG8_LDA(At, 1, 0); PG8_STAGE(PG8_SA(0, 1), a2 + hstep, voffA);
            PG8_WAIT_L(8); PG8_BAR; PG8_WAIT_L(0); PG8_MMA(0, 0, At, B0); PG8_BAR; PG8_SCHED;
            PG8_LDB(B1, 1, 1); PG8_STAGE(PG8_SB(1, 0), b3, voffB);
            PG8_BAR; PG8_WAIT_L(0); PG8_MMA(0, 1, At, B1); PG8_BAR;
            PG8_LDA(At, 1, 1); PG8_STAGE(PG8_SA(1, 0), a3, voffA);
            PG8_BAR; PG8_WAIT_L(0); PG8_MMA(1, 0, At, B0); PG8_BAR; PG8_SCHED;
            PG8_STAGE(PG8_SB(1, 1), b3 + hstep, voffB);
            PG8_WAIT_V(6); PG8_BAR; PG8_MMA(1, 1, At, B1); PG8_BAR;
            }
        }
        if constexpr (ALIGN_EPI) { if (wr == 0) PG8_BAR; }
        if constexpr (!Epi::AFTER_DRAIN) { E(acc, cur, wr, wc, fr, fq); S.done(cur); }
        if (!has_next) break;
#pragma unroll
        for (int a = 0; a < 2; ++a)
#pragma unroll
            for (int b = 0; b < 2; ++b)
#pragma unroll
                for (int m = 0; m < 4; ++m)
#pragma unroll
                    for (int n = 0; n < 2; ++n) acc[a][b][m][n] = (f32x4){0.f, 0.f, 0.f, 0.f};
        cur = nxt; cA = nA; cB = nB; ++ui;
        if constexpr (ALIGN_EPI) { if (wr == 1) PG8_BAR; }
    }
    PG8_WAIT_V(0);
    if constexpr (!ALIGN_EPI) { if (wr == 0) PG8_BAR; }
    PG8_BAR;
    if constexpr (Epi::AFTER_DRAIN) { E.fused(acc, cur, wr, wc, fr, fq, lds, wid, lane); S.done(cur); }
#undef PG8_SA
#undef PG8_SB
#undef PG8_STAGE
#undef PG8_LDA
#undef PG8_LDB
#undef PG8_MMA
#undef PG8_WAIT_V
#undef PG8_WAIT_L
#undef PG8_BAR
#undef PG8_SCHED
}
}

#define LAS __attribute__((address_space(3)))
typedef unsigned short bf16;
typedef short bf16x8 __attribute__((ext_vector_type(8)));
typedef float f32x4 __attribute__((ext_vector_type(4)));
typedef float f32x16 __attribute__((ext_vector_type(16)));
typedef unsigned u32x4 __attribute__((ext_vector_type(4)));
typedef unsigned u32x2 __attribute__((ext_vector_type(2)));
typedef short s16x4 __attribute__((ext_vector_type(4)));

constexpr int D = 1024, FF = 2816, M = 16384, MCTX = 8192, NMOD = 9216;
constexpr int NWAVES = 8, NTHR = 512;
constexpr float LOG2E = 1.4426950408889634f;
constexpr float QSCALE = 0.125f * LOG2E;
constexpr float LAM_INIT = 0.35550906759096934f;
constexpr float EPS = 1e-6f;

constexpr size_t MiB = 1u << 20;
constexpr size_t WS_MODS = 1 * MiB;
constexpr size_t WS_ROPE = 1 * MiB + 512 * 1024;
constexpr size_t WS_CACHE = 2 * MiB;
constexpr size_t WS_WF = 8 * MiB;
constexpr size_t WS_WMI0 = 76 * MiB, WS_WMI1 = 80 * MiB, WS_WMO0 = 86 * MiB, WS_WMO1 = 88 * MiB;
constexpr size_t WS_H = 96 * MiB, WS_Y = 128 * MiB, WS_ACT = 160 * MiB, WS_END = 256 * MiB;

constexpr int LDS_BYTES = 147456;

__device__ const double ROPE_INV[16] = {1.0, 0.5623413251903491, 0.31622776601683794, 0.1778279410038923, 0.1, 0.05623413251903491, 0.03162277660168379,
    0.01778279410038923, 0.01, 0.005623413251903491, 0.0031622776601683794, 0.0017782794100389228, 0.001, 0.0005623413251903491, 0.00031622776601683794, 0.00017782794100389227};

struct Args { const float* in[27]; float* out; unsigned char* ws; };

__device__ __forceinline__ float wave_sum(float v) {
#pragma unroll
    for (int o = 1; o < 64; o <<= 1) v += __shfl_xor(v, o);
    return v;
}
__device__ __forceinline__ unsigned pk2(float lo, float hi) { return pg8::cvt_pk_bf16(lo, hi); }
__device__ __forceinline__ float bf_lo(unsigned w) { return __uint_as_float(w << 16); }
__device__ __forceinline__ float bf_hi(unsigned w) { return __uint_as_float(w & 0xffff0000u); }
__device__ __forceinline__ float fast_exp2(float x) { return __builtin_amdgcn_exp2f(x); }
__device__ __forceinline__ float silu_f(float x) { return x * __builtin_amdgcn_rcpf(1.0f + fast_exp2(-x * LOG2E)); }
__device__ __forceinline__ int cond_of_row(int row) { return row < MCTX ? 0 : 1 + ((row - MCTX) >> 12); }

struct EpiSwiglu {
    static constexpr bool PERM = true, AFTER_DRAIN = false;
    bf16* O;
    __device__ __forceinline__ void operator()(const f32x4 (&acc)[2][2][4][2], const pg8::Unit& u, int wr, int wc, int fr_, int fq_) const {
        int fr = fr_, fq = fq_; asm volatile("" : "+v"(fr), "+v"(fq));
        const int row0 = u.pm * 256 + wr * 64 + fr, col0 = u.pn * 128 + wc * 32 + 8 * fq;
#pragma unroll
        for (int ai = 0; ai < 2; ++ai)
#pragma unroll
            for (int m = 0; m < 4; ++m) {
                bf16* rowp = O + (size_t)(row0 + ai * 128 + m * 16) * FF + col0;
                const f32x4 a0 = acc[ai][0][m][0], a1 = acc[ai][0][m][1], b0 = acc[ai][1][m][0], b1 = acc[ai][1][m][1];
                u32x4 w;
                w.x = pk2(silu_f(a0[0]) * b0[0], silu_f(a0[1]) * b0[1]); w.y = pk2(silu_f(a0[2]) * b0[2], silu_f(a0[3]) * b0[3]);
                w.z = pk2(silu_f(a1[0]) * b1[0], silu_f(a1[1]) * b1[1]); w.w = pk2(silu_f(a1[2]) * b1[2], silu_f(a1[3]) * b1[3]);
                *(u32x4*)rowp = w;
            }
    }
};
struct EpiBf16P {
    static constexpr bool PERM = true, AFTER_DRAIN = false;
    bf16* O; int ldc;
    __device__ __forceinline__ void operator()(const f32x4 (&acc)[2][2][4][2], const pg8::Unit& u, int wr, int wc, int fr_, int fq_) const {
        int fr = fr_, fq = fq_; asm volatile("" : "+v"(fr), "+v"(fq));
        const int row0 = u.pm * 256 + wr * 64 + fr, col0 = u.pn * 256 + wc * 32 + 8 * fq;
#pragma unroll
        for (int ai = 0; ai < 2; ++ai)
#pragma unroll
            for (int m = 0; m < 4; ++m) {
                bf16* rowp = O + (size_t)(row0 + ai * 128 + m * 16) * ldc + col0;
#pragma unroll
                for (int bj = 0; bj < 2; ++bj) {
                    const f32x4 v0 = acc[ai][bj][m][0], v1 = acc[ai][bj][m][1];
                    u32x4 w; w.x = pk2(v0[0], v0[1]); w.y = pk2(v0[2], v0[3]); w.z = pk2(v1[0], v1[1]); w.w = pk2(v1[2], v1[3]);
                    *(u32x4*)(rowp + bj * 128) = w;
                }
            }
    }
};
struct EpiResid {
    static constexpr bool PERM = false, AFTER_DRAIN = false;
    const float* base_c; const float* base_l; float* X; const float* gate; float gs;
    __device__ __forceinline__ void operator()(const f32x4 (&acc)[2][2][4][2], const pg8::Unit& u, int wr, int wc, int fr_, int fq_) const {
        int fr = fr_, fq = fq_; asm volatile("" : "+v"(fr), "+v"(fq));
        const int rowt = u.pm * 256, row0 = rowt + wr * 64 + fr, col0 = u.pn * 256 + wc * 32 + 4 * fq;
        const float* gp = gate + (size_t)cond_of_row(rowt) * NMOD + col0;
        const float* bp = rowt < MCTX ? base_c + (size_t)row0 * D : base_l + (size_t)(row0 - MCTX) * D;
        float* xp = X + (size_t)row0 * D + col0;
        bp += col0;
        f32x4 gv[2][2];
#pragma unroll
        for (int bj = 0; bj < 2; ++bj)
#pragma unroll
            for (int n = 0; n < 2; ++n) gv[bj][n] = *(const f32x4*)(gp + bj * 128 + n * 16) * gs;
#pragma unroll
        for (int ai = 0; ai < 2; ++ai)
#pragma unroll
            for (int m = 0; m < 4; ++m) {
                const size_t ro = (size_t)(ai * 128 + m * 16) * D;
#pragma unroll
                for (int bj = 0; bj < 2; ++bj)
#pragma unroll
                    for (int n = 0; n < 2; ++n) {
                        const f32x4 b = *(const f32x4*)(bp + ro + bj * 128 + n * 16);
                        *(f32x4*)(xp + ro + bj * 128 + n * 16) = b + gv[bj][n] * acc[ai][bj][m][n];
                    }
            }
    }
};
struct EpiOdd {
    static constexpr bool PERM = false, AFTER_DRAIN = false;
    bf16* U; float* newc; const float* rope;
    __device__ __forceinline__ void operator()(const f32x4 (&acc)[2][2][4][2], const pg8::Unit& u, int wr, int wc, int fr_, int fq_) const {
        int fr = fr_, fq = fq_; asm volatile("" : "+v"(fr), "+v"(fq));
        const int rowt = u.pm * 256, row0 = rowt + wr * 64 + fr, pn = u.pn;
        const int colt = pn * 256 + wc * 32 + 4 * fq;
        const bool ctx = rowt < MCTX;
        const float sc = (pn < 2 || (pn == 6 || pn == 7)) ? QSCALE : 1.0f;
        const bool do_rope = (!ctx) && (pn >= 6 && pn <= 9);
        const int oidx = (pn == 2 || pn == 3) ? 0 : (pn == 4 || pn == 5) ? 1 : (pn == 8 || pn == 9) ? 2 : (pn >= 10) ? 3 : -1;
        float* np = newc + (size_t)(oidx < 0 ? 0 : oidx) * ((size_t)MCTX * 512) + (size_t)(pn & 1) * 256 + wc * 32 + 4 * fq;
#pragma unroll
        for (int ai = 0; ai < 2; ++ai)
#pragma unroll
            for (int m = 0; m < 4; ++m) {
                const int row = row0 + ai * 128 + m * 16;
                bf16* up = U + (size_t)row * 3072 + colt;
                f32x4 cs = {1.f, 1.f, 1.f, 1.f}, sn = {0.f, 0.f, 0.f, 0.f};
                if (do_rope) {
                    const int t = (row - MCTX) & 4095;
                    const int pos = (wc & 1) ? (t & 63) : (t >> 6);
                    cs = *(const f32x4*)(rope + pos * 16 + 4 * fq); sn = *(const f32x4*)(rope + 1024 + pos * 16 + 4 * fq);
                }
#pragma unroll
                for (int bj = 0; bj < 2; ++bj) {
                    const f32x4 x1 = acc[ai][bj][m][0], x2 = acc[ai][bj][m][1];
                    if (ctx && oidx >= 0) {
                        *(f32x4*)(np + (size_t)row * 512 + bj * 128) = x1;
                        *(f32x4*)(np + (size_t)row * 512 + bj * 128 + 16) = x2;
                    }
                    const f32x4 o1 = (x1 * cs - x2 * sn) * sc, o2 = (x2 * cs + x1 * sn) * sc;
                    u32x2 w1, w2; w1.x = pk2(o1[0], o1[1]); w1.y = pk2(o1[2], o1[3]); w2.x = pk2(o2[0], o2[1]); w2.y = pk2(o2[2], o2[3]);
                    *(u32x2*)(up + bj * 128) = w1; *(u32x2*)(up + bj * 128 + 16) = w2;
                }
            }
    }
};

template <class Epi> __device__ __forceinline__ void run_gemm(LAS unsigned char* lds, const bf16* A, const bf16* Bt, int N, int K, const Epi& E) {
    pg8::Gemm g{A, Bt, M, N, K}; pg8::StaticOrder S; S.init(M, N, (int)gridDim.x, (int)blockIdx.x);
    pg8::gemm_phase<Epi, pg8::StaticOrder, true, true>(lds, g, S, E);
}

__device__ __forceinline__ void tr_item(const float* W, int N, bf16* WT, int ldt, int k0, int n0, int dst_row0, LAS float* scr, int lane) {
#pragma unroll 8
    for (int i = 0; i < 32; ++i) { const int kk = 2 * i + (lane >> 5); scr[kk * 33 + (lane & 31)] = W[(size_t)(k0 + kk) * N + n0 + (lane & 31)]; }
    asm volatile("s_waitcnt lgkmcnt(0)" ::: "memory");
    const int c = lane & 7;
#pragma unroll
    for (int j = 0; j < 4; ++j) { const int n = (lane >> 3) + 8 * j; const LAS float* s = scr + (8 * c) * 33 + n;
        u32x4 o; o.x = pk2(s[0 * 33], s[1 * 33]); o.y = pk2(s[2 * 33], s[3 * 33]); o.z = pk2(s[4 * 33], s[5 * 33]); o.w = pk2(s[6 * 33], s[7 * 33]);
        *(u32x4*)(WT + (size_t)(dst_row0 + n) * ldt + k0 + 8 * c) = o; }
    asm volatile("s_waitcnt lgkmcnt(0)" ::: "memory");
}
__device__ __forceinline__ int swiglu_row(int n0) { return n0 < FF ? 256 * (n0 >> 7) + (n0 & 127) : 256 * ((n0 - FF) >> 7) + 128 + ((n0 - FF) & 127); }

__device__ __forceinline__ void p0_weights(const Args& a, LAS unsigned char* lds, int gw, int NGW, int wave, int lane) {
    asm volatile("" : "+v"(lane));
    LAS float* scr = (LAS float*)(lds + wave * 16384);
    unsigned char* ws = a.ws;
    constexpr int I_IN = 16 * 176, I_OUT = 44 * 32, I_LF = I_IN + I_OUT, I_FFN = 4 * I_LF;
    constexpr int I_EV = 16 * 64, I_OD = 16 * 96, I_MO0 = 8 * 32, I_MO1 = 16 * 32;
    constexpr int NITEMS = I_FFN + I_EV + I_OD + I_MO0 + I_MO1;
    for (int it = gw; it < NITEMS; it += NGW) {
        int r = it;
        if (r < I_FFN) {
            const int lf = r / I_LF; r -= lf * I_LF; const int l = lf >> 1, f = lf & 1;
            bf16* slot = (bf16*)(ws + WS_WF + (size_t)lf * 17 * MiB);
            if (r < I_IN) { const float* W = a.in[f ? 24 : 11] + (size_t)l * D * 2 * FF; const int kb = r / 176, nb = r % 176;
                tr_item(W, 2 * FF, slot, D, 64 * kb, 32 * nb, swiglu_row(32 * nb), scr, lane); }
            else { r -= I_IN; const float* W = a.in[f ? 25 : 12] + (size_t)l * FF * D; const int kb = r / 32, nb = r % 32;
                tr_item(W, D, (bf16*)((unsigned char*)slot + 11 * MiB), FF, 64 * kb, 32 * nb, 32 * nb, scr, lane); }
            continue;
        }
        r -= I_FFN;
        if (r < I_EV) { const int kb = r / 64, nb = r % 64; tr_item(a.in[14], 2048, (bf16*)(ws + WS_WMI0), D, 64 * kb, 32 * nb, 32 * nb, scr, lane); continue; }
        r -= I_EV;
        if (r < I_OD) { const int kb = r / 96, nb = r % 96; tr_item(a.in[18], 3072, (bf16*)(ws + WS_WMI1), D, 64 * kb, 32 * nb, 32 * nb, scr, lane); continue; }
        r -= I_OD;
        if (r < I_MO0) { const int kb = r / 32, nb = r % 32; tr_item(a.in[22], D, (bf16*)(ws + WS_WMO0), D, 512 + 64 * kb, 32 * nb, 32 * nb, scr, lane); continue; }
        r -= I_MO0;
        { const int kb = r / 32, nb = r % 32; tr_item(a.in[22] + (size_t)D * D, D, (bf16*)(ws + WS_WMO1), D, 64 * kb, 32 * nb, 32 * nb, scr, lane); }
    }
    for (int it = gw; it < 4096; it += NGW) {
        const int arr = it >> 10, chunk = it & 1023;
        const float* src = a.in[2 + arr] + (size_t)chunk * 512 + lane * 8;
        const f32x4 v0 = *(const f32x4*)src, v1 = *(const f32x4*)(src + 4);
        u32x4 o; o.x = pk2(v0[0], v0[1]); o.y = pk2(v0[2], v0[3]); o.z = pk2(v1[0], v1[1]); o.w = pk2(v1[2], v1[3]);
        *(u32x4*)((bf16*)(ws + WS_CACHE + (size_t)arr * MiB) + (size_t)chunk * 512 + lane * 8) = o;
    }
    for (int it = gw; it < 1024; it += NGW) {
        const int k0 = (it >> 4) * 8, g = k0 >> 7, n = (it & 15) * 64 + lane;
        const float* pw = a.in[15] + (size_t)k0 * 128; const float* ps = a.in[16] + g * 128; const float* wo = a.in[22] + (size_t)(g * 128) * D + n;
        float acc[8];
#pragma unroll
        for (int i = 0; i < 8; ++i) acc[i] = 0.f;
        for (int dd = 0; dd < 128; ++dd) {
            const float w = wo[(size_t)dd * D] * ps[dd];
#pragma unroll
            for (int i = 0; i < 8; ++i) acc[i] += pw[i * 128 + dd] * w;
        }
        u32x4 o; o.x = pk2(acc[0], acc[1]); o.y = pk2(acc[2], acc[3]); o.z = pk2(acc[4], acc[5]); o.w = pk2(acc[6], acc[7]);
        *(u32x4*)((bf16*)(ws + WS_WMO0) + (size_t)n * D + k0) = o;
    }
    if (gw < 16) {
        const int idx = gw * 64 + lane, pos = idx >> 4, i = idx & 15;
        const double ang = (double)pos * ROPE_INV[i];
        const double kq = __builtin_rint(ang * 0.63661977236758134308);
        const double rr = (ang - kq * 1.57079632679489655800) - kq * 6.123233995736766e-17;
        const double r2 = rr * rr;
        double sp = 1.0 / 1307674368000.0 * -1.0;
        sp = sp * r2 + 1.0 / 6227020800.0; sp = sp * r2 - 1.0 / 39916800.0; sp = sp * r2 + 1.0 / 362880.0; sp = sp * r2 - 1.0 / 5040.0; sp = sp * r2 + 1.0 / 120.0; sp = sp * r2 - 1.0 / 6.0; sp = sp * r2 + 1.0;
        const double s = sp * rr;
        double cp = 1.0 / 20922789888000.0;
        cp = cp * r2 - 1.0 / 87178291200.0; cp = cp * r2 + 1.0 / 479001600.0; cp = cp * r2 - 1.0 / 3628800.0; cp = cp * r2 + 1.0 / 40320.0; cp = cp * r2 - 1.0 / 720.0; cp = cp * r2 + 1.0 / 24.0; cp = cp * r2 - 0.5; cp = cp * r2 + 1.0;
        const int q = ((int)kq) & 3;
        const double cv = (q == 0) ? cp : (q == 1) ? -s : (q == 2) ? -cp : s;
        const double sv = (q == 0) ? s : (q == 1) ? cp : (q == 2) ? -s : -cp;
        float* rope = (float*)(ws + WS_ROPE);
        rope[idx] = (float)cv; rope[1024 + idx] = (float)sv;
    }
}
__device__ __forceinline__ void p0_mods(const Args& a, LAS unsigned char* lds, int tid) {
    asm volatile("" : "+v"(tid));
    LAS float* sc = (LAS float*)lds;
    LAS float* red = (LAS float*)(lds + 12288);
    float* mods = (float*)(a.ws + WS_MODS);
    for (int u = blockIdx.x; u < 144; u += gridDim.x) {
        const int l = u / 72, n0 = (u % 72) * 128;
        for (int i = tid; i < 3072; i += NTHR) { const int c = i >> 10, k = i & 1023; const float v = (c == 0) ? a.in[7][k] : a.in[6][(c - 1) * D + k]; sc[i] = v / (1.0f + __expf(-v)); }
        __syncthreads();
        const int cgp = tid & 31, kg = tid >> 5;
        const float* wp = a.in[8] + ((size_t)l * D + kg * 64) * NMOD + n0 + cgp * 4;
        f32x4 a0 = {0.f, 0.f, 0.f, 0.f}, a1 = a0, a2 = a0;
#pragma unroll 4
        for (int k = 0; k < 64; ++k) { const f32x4 w = *(const f32x4*)(wp + (size_t)k * NMOD); const int kk = kg * 64 + k; a0 += w * sc[kk]; a1 += w * sc[1024 + kk]; a2 += w * sc[2048 + kk]; }
        *(LAS f32x4*)(red + (kg * 3 + 0) * 128 + cgp * 4) = a0; *(LAS f32x4*)(red + (kg * 3 + 1) * 128 + cgp * 4) = a1; *(LAS f32x4*)(red + (kg * 3 + 2) * 128 + cgp * 4) = a2;
        __syncthreads();
        if (tid < 384) { const int c = tid >> 7, n = tid & 127; float s = a.in[9][(size_t)l * NMOD + n0 + n];
#pragma unroll
            for (int kgi = 0; kgi < 16; ++kgi) s += red[(kgi * 3 + c) * 128 + n];
            mods[((size_t)l * 3 + c) * NMOD + n0 + n] = s; }
        __syncthreads();
    }
}

__device__ __forceinline__ void norm_phase(const float* bc, const float* bl, const float* g, const float* shift, const float* scale, bf16* H, int gw, int NGW, int lane) {
    asm volatile("" : "+v"(lane));
    for (int row = gw; row < M; row += NGW) {
        const float* xr = row < MCTX ? bc + (size_t)row * D : bl + (size_t)(row - MCTX) * D;
        const int co = cond_of_row(row) * NMOD;
        f32x4 v[4]; float ss = 0.f;
#pragma unroll
        for (int j = 0; j < 4; ++j) { v[j] = *(const f32x4*)(xr + 4 * (lane + 64 * j)); ss += (v[j][0] * v[j][0] + v[j][1] * v[j][1]) + (v[j][2] * v[j][2] + v[j][3] * v[j][3]); }
        const float rs = 1.0f / sqrtf(wave_sum(ss) * (1.0f / D) + EPS);
#pragma unroll
        for (int j = 0; j < 4; ++j) {
            const int col = 4 * (lane + 64 * j);
            const f32x4 gg = *(const f32x4*)(g + col), sc = *(const f32x4*)(scale + co + col), sh = *(const f32x4*)(shift + co + col);
            const f32x4 y = (v[j] * rs) * gg * (sc + 1.0f) + sh;
            u32x2 w; w.x = pk2(y[0], y[1]); w.y = pk2(y[2], y[3]);
            *(u32x2*)(H + (size_t)row * D + col) = w;
        }
    }
}
__device__ __forceinline__ void final_norm_phase(float* X, const float* g, int gw, int NGW, int lane) {
    asm volatile("" : "+v"(lane));
    for (int row = gw; row < M; row += NGW) {
        float* xr = X + (size_t)row * D;
        f32x4 v[4]; float ss = 0.f;
#pragma unroll
        for (int j = 0; j < 4; ++j) { v[j] = *(const f32x4*)(xr + 4 * (lane + 64 * j)); ss += (v[j][0] * v[j][0] + v[j][1] * v[j][1]) + (v[j][2] * v[j][2] + v[j][3] * v[j][3]); }
        const float rs = 1.0f / sqrtf(wave_sum(ss) * (1.0f / D) + EPS);
#pragma unroll
        for (int j = 0; j < 4; ++j) { const int col = 4 * (lane + 64 * j); *(f32x4*)(xr + col) = (v[j] * rs) * *(const f32x4*)(g + col); }
    }
}

__device__ __forceinline__ void unpack8(const u32x4 w, float (&f)[8]) { f[0] = bf_lo(w.x); f[1] = bf_hi(w.x); f[2] = bf_lo(w.y); f[3] = bf_hi(w.y); f[4] = bf_lo(w.z); f[5] = bf_hi(w.z); f[6] = bf_lo(w.w); f[7] = bf_hi(w.w); }
__device__ __forceinline__ void even_core_phase(const bf16* U, const float* conv_w, bf16* Y, int gtid, int NT) {
    asm volatile("" : "+v"(gtid));
    for (int idx = gtid; idx < M * 128; idx += NT) {
        const int row = idx >> 7, c8 = idx & 127;
        int n, t;
        if (row < MCTX) { n = 256; t = row & 255; } else { n = 4096; t = (row - MCTX) & 4095; }
        float o[8];
        if (c8 < 64) {
            const int half = 1 << (c8 >> 4);
            const int lo = (t - half) > 0 ? (t - half) : 0, hi = (t + half - 1) < (n - 1) ? (t + half - 1) : (n - 1);
            const bf16* up = U + (size_t)(row - t) * 2048 + c8 * 8;
            float s[8], x[8];
#pragma unroll
            for (int i = 0; i < 8; ++i) s[i] = 0.f;
            for (int tt = lo; tt <= hi; ++tt) { float f[8]; unpack8(*(const u32x4*)(up + (size_t)tt * 2048), f);
#pragma unroll
                for (int i = 0; i < 8; ++i) s[i] += f[i]; }
            unpack8(*(const u32x4*)(up + (size_t)t * 2048), x);
            const float inv = 1.0f / (float)(hi - lo + 1);
#pragma unroll
            for (int i = 0; i < 8; ++i) o[i] = s[i] * inv - x[i];
        } else {
            const int ch = (c8 - 64) * 8;
            const bf16* up = U + (size_t)row * 2048 + 512 + ch;
            float z[3][8], gb[8];
#pragma unroll
            for (int j = 0; j < 3; ++j) {
                const int tt = t + j - 1;
                if (tt >= 0 && tt < n) { float h[8], gc[8]; unpack8(*(const u32x4*)(up + (ptrdiff_t)(j - 1) * 2048), h); unpack8(*(const u32x4*)(up + (ptrdiff_t)(j - 1) * 2048 + 1024), gc);
#pragma unroll
                    for (int i = 0; i < 8; ++i) z[j][i] = gc[i] * h[i]; }
                else {
#pragma unroll
                    for (int i = 0; i < 8; ++i) z[j][i] = 0.f; }
            }
            unpack8(*(const u32x4*)(up + 512), gb);
            const f32x4 w0a = *(const f32x4*)(conv_w + ch), w0b = *(const f32x4*)(conv_w + ch + 4), w1a = *(const f32x4*)(conv_w + 512 + ch), w1b = *(const f32x4*)(conv_w + 512 + ch + 4),
                        w2a = *(const f32x4*)(conv_w + 1024 + ch), w2b = *(const f32x4*)(conv_w + 1024 + ch + 4);
#pragma unroll
            for (int i = 0; i < 4; ++i) { o[i] = gb[i] * (z[0][i] * w0a[i] + z[1][i] * w1a[i] + z[2][i] * w2a[i]); o[4 + i] = gb[4 + i] * (z[0][4 + i] * w0b[i] + z[1][4 + i] * w1b[i] + z[2][4 + i] * w2b[i]); }
        }
        u32x4 w; w.x = pk2(o[0], o[1]); w.y = pk2(o[2], o[3]); w.z = pk2(o[4], o[5]); w.w = pk2(o[6], o[7]);
        *(u32x4*)(Y + (size_t)row * D + c8 * 8) = w;
    }
}

constexpr int AT_KS = 144, AT_KBYTES = 2 * 64 * AT_KS;
constexpr int AT_VBYTES = 24576, AT_STAGE = AT_KBYTES + AT_VBYTES;
constexpr int AT_RPB = 2 * AT_STAGE;
struct AttnUnit {
    const bf16* Q; int ldq;
    int qcol0, qcol1;
    const bf16 *K00, *K01, *K10, *K11, *V00, *V01, *V10, *V11; int ld0, ld1, nt0, nt1;
    bf16* Y; int ycol0, ycol1;
    int rq0, krlo;
    const float* rpb;
};
__device__ __forceinline__ s16x4 tr_read(const LAS unsigned char* p) { return __builtin_amdgcn_ds_read_tr16_b64_v4i16((LAS s16x4*)p); }

template <int DV, int MODE>
__device__ __forceinline__ void attn_unit(LAS unsigned char* lds, const AttnUnit& A, float lam, const float* dnorm, int tid) {
    asm volatile("" : "+v"(tid));
    const int lane = tid & 63, wave = __builtin_amdgcn_readfirstlane(tid >> 6), s = wave >> 2, wq = wave & 3, ql = lane & 31, h = lane >> 5;
    constexpr int NEB = DV / 32, VS = (DV == 64) ? 192 : 320;
    const int kr_ = (tid >> 3) & 63, kc_ = tid & 7;
    const int vr_ = (DV == 64) ? kr_ : (tid >> 4), vc_ = (DV == 64) ? kc_ : (tid & 15);
    const unsigned k_lds0 = 0 * 64 * AT_KS + kr_ * AT_KS + kc_ * 16, k_lds1 = 64 * AT_KS + kr_ * AT_KS + kc_ * 16;
    const unsigned v_lds0 = AT_KBYTES + vr_ * VS + vc_ * 16, v_lds1 = AT_KBYTES + ((DV == 64) ? (64 * 192 + vr_ * VS + vc_ * 16) : ((vr_ + 32) * VS + vc_ * 16));
    u32x4 kreg0, kreg1, vreg0, vreg1;
    const int nt0 = A.nt0, ntot = A.nt0 + A.nt1;
#define AT_LOAD(t) do { const bool sg_ = (t) >= nt0; const int tt_ = (t) - (sg_ ? nt0 : 0); const int ld_ = sg_ ? A.ld1 : A.ld0; const size_t ro_ = (size_t)(tt_ * 64) * ld_; \
        const bf16* k0_ = sg_ ? A.K10 : A.K00; const bf16* k1_ = sg_ ? A.K11 : A.K01; const bf16* v0_ = sg_ ? A.V10 : A.V00; const bf16* v1_ = sg_ ? A.V11 : A.V01; \
        kreg0 = *(const u32x4*)(k0_ + ro_ + (size_t)kr_ * ld_ + kc_ * 8); kreg1 = *(const u32x4*)(k1_ + ro_ + (size_t)kr_ * ld_ + kc_ * 8); \
        if (DV == 64) { vreg0 = *(const u32x4*)(v0_ + ro_ + (size_t)vr_ * ld_ + vc_ * 8); vreg1 = *(const u32x4*)(v1_ + ro_ + (size_t)vr_ * ld_ + vc_ * 8); } \
        else { vreg0 = *(const u32x4*)(v0_ + ro_ + (size_t)vr_ * ld_ + vc_ * 8); vreg1 = *(const u32x4*)(v0_ + ro_ + (size_t)(vr_ + 32) * ld_ + vc_ * 8); } } while (0)
#define AT_STORE(b) do { LAS unsigned char* sb_ = lds + (b) * AT_STAGE; *(LAS u32x4*)(sb_ + k_lds0) = kreg0; *(LAS u32x4*)(sb_ + k_lds1) = kreg1; *(LAS u32x4*)(sb_ + v_lds0) = vreg0; *(LAS u32x4*)(sb_ + v_lds1) = vreg1; } while (0)
    const int qrow = 32 * wq + ql;
    bf16x8 qf[4];
#pragma unroll
    for (int ds = 0; ds < 4; ++ds) qf[ds] = *(const bf16x8*)(A.Q + (size_t)qrow * A.ldq + (s ? A.qcol1 : A.qcol0) + 16 * ds + 8 * h);
    int rq = 0, r0q = 0, cq = 0, c0 = 0;
    LAS float* rpbs = (LAS float*)(lds + AT_RPB);
    if (MODE == 1) {
        rq = A.rq0 + (wq >> 1); r0q = rq - 4; r0q = r0q < 0 ? 0 : (r0q > 56 ? 56 : r0q);
        cq = 32 * (wq & 1) + ql; c0 = cq - 8; c0 = c0 < 0 ? 0 : (c0 > 48 ? 48 : c0);
        for (int i = tid; i < 930; i += NTHR) rpbs[i] = A.rpb[i] * LOG2E;
    }
    f32x16 o[NEB];
#pragma unroll
    for (int eb = 0; eb < NEB; ++eb)
#pragma unroll
        for (int r = 0; r < 16; ++r) o[eb][r] = 0.f;
    float mrun = -1e30f, lrun = 0.f;
    const LAS unsigned char* kbase = lds + s * 64 * AT_KS + ql * AT_KS + 16 * h;
    const LAS unsigned char* vbase = lds + AT_KBYTES + ((DV == 64) ? s * 64 * 192 : 0) + (4 * h + ((lane & 15) >> 2)) * VS + (16 * ((lane >> 4) & 1) + 4 * (lane & 3)) * 2;

    AT_LOAD(0); AT_STORE(0);
    __syncthreads();
    for (int t = 0; t < ntot; ++t) {
        const int buf = t & 1;
        if (t + 1 < ntot) AT_LOAD(t + 1);
        bool vis = true; int kr = 0;
        if (MODE == 1 && t >= nt0) { kr = A.krlo + (t - nt0); vis = (kr >= r0q) && (kr < r0q + 8); }
        if (vis) {
            const LAS unsigned char* kb = kbase + buf * AT_STAGE;
            f32x16 p0, p1;
#pragma unroll
            for (int r = 0; r < 16; ++r) { p0[r] = 0.f; p1[r] = 0.f; }
#pragma unroll
            for (int ds = 0; ds < 4; ++ds) {
                const bf16x8 a0 = *(const LAS bf16x8*)(kb + 32 * ds), a1 = *(const LAS bf16x8*)(kb + 32 * AT_KS + 32 * ds);
                p0 = __builtin_amdgcn_mfma_f32_32x32x16_bf16(a0, qf[ds], p0, 0, 0, 0);
                p1 = __builtin_amdgcn_mfma_f32_32x32x16_bf16(a1, qf[ds], p1, 0, 0, 0);
            }
            if (MODE == 1 && t >= nt0) {
                const LAS float* bp = rpbs + s * 465 + (kr - rq + 7) * 31 + 15 - cq;
#pragma unroll
                for (int r = 0; r < 16; ++r) {
                    const int kc0 = (r & 3) + 8 * (r >> 2) + 4 * h, kc1 = kc0 + 32;
                    p0[r] = (kc0 >= c0 && kc0 < c0 + 16) ? p0[r] + bp[kc0] : -1e30f;
                    p1[r] = (kc1 >= c0 && kc1 < c0 + 16) ? p1[r] + bp[kc1] : -1e30f;
                }
            }
            float mt = fmaxf(p0[0], p1[0]);
#pragma unroll
            for (int r = 1; r < 16; ++r) mt = fmaxf(mt, fmaxf(p0[r], p1[r]));
            mt = fmaxf(mt, __shfl_xor(mt, 32));
            const float mnew = fmaxf(mrun, mt), alpha = fast_exp2(mrun - mnew);
            mrun = mnew;
            float ps = 0.f;
#pragma unroll
            for (int r = 0; r < 16; ++r) { p0[r] = fast_exp2(p0[r] - mnew); p1[r] = fast_exp2(p1[r] - mnew); ps += p0[r] + p1[r]; }
            lrun = lrun * alpha + ps;
            bf16x8 pb[2][2];
#pragma unroll
            for (int s2 = 0; s2 < 2; ++s2) {
                u32x4 w0, w1;
                w0.x = pk2(p0[8 * s2 + 0], p0[8 * s2 + 1]); w0.y = pk2(p0[8 * s2 + 2], p0[8 * s2 + 3]); w0.z = pk2(p0[8 * s2 + 4], p0[8 * s2 + 5]); w0.w = pk2(p0[8 * s2 + 6], p0[8 * s2 + 7]);
                w1.x = pk2(p1[8 * s2 + 0], p1[8 * s2 + 1]); w1.y = pk2(p1[8 * s2 + 2], p1[8 * s2 + 3]); w1.z = pk2(p1[8 * s2 + 4], p1[8 * s2 + 5]); w1.w = pk2(p1[8 * s2 + 6], p1[8 * s2 + 7]);
                pb[0][s2] = __builtin_bit_cast(bf16x8, w0); pb[1][s2] = __builtin_bit_cast(bf16x8, w1);
            }
            const LAS unsigned char* vb = vbase + buf * AT_STAGE;
#pragma unroll
            for (int eb = 0; eb < NEB; ++eb) {
                __builtin_amdgcn_sched_barrier(0);
#pragma unroll
                for (int r = 0; r < 16; ++r) o[eb][r] *= alpha;
#pragma unroll
                for (int kbk = 0; kbk < 2; ++kbk)
#pragma unroll
                    for (int s2 = 0; s2 < 2; ++s2) {
                        const s16x4 lo = tr_read(vb + (kbk * 32 + 16 * s2) * VS + eb * 64), hi = tr_read(vb + (kbk * 32 + 16 * s2 + 8) * VS + eb * 64);
                        const bf16x8 av = {lo[0], lo[1], lo[2], lo[3], hi[0], hi[1], hi[2], hi[3]};
                        o[eb] = __builtin_amdgcn_mfma_f32_32x32x16_bf16(av, pb[kbk][s2], o[eb], 0, 0, 0);
                    }
            }
        }
        if (t + 1 < ntot) AT_STORE(buf ^ 1);
        __syncthreads();
    }
#undef AT_LOAD
#undef AT_STORE
    const float ltot = lrun + __shfl_xor(lrun, 32), linv = 1.0f / ltot;
    if (DV == 64) {
        bf16* yp = A.Y + (size_t)qrow * D + (s ? A.ycol1 : A.ycol0) + 4 * h;
#pragma unroll
        for (int eb = 0; eb < NEB; ++eb)
#pragma unroll
            for (int r4 = 0; r4 < 4; ++r4) { u32x2 w; w.x = pk2(o[eb][4 * r4] * linv, o[eb][4 * r4 + 1] * linv); w.y = pk2(o[eb][4 * r4 + 2] * linv, o[eb][4 * r4 + 3] * linv);
                *(u32x2*)(yp + eb * 32 + 8 * r4) = w; }
    } else {
        LAS float* xs = (LAS float*)lds + (size_t)wq * (NEB * 16 * 64) + lane;
        if (s == 1) { const float f = lam * linv;
#pragma unroll
            for (int eb = 0; eb < NEB; ++eb)
#pragma unroll
                for (int r = 0; r < 16; ++r) xs[(eb * 16 + r) * 64] = o[eb][r] * f; }
        __syncthreads();
        if (s == 0) {
            float ss = 0.f;
#pragma unroll
            for (int eb = 0; eb < NEB; ++eb)
#pragma unroll
                for (int r = 0; r < 16; ++r) { const float v = o[eb][r] * linv - xs[(eb * 16 + r) * 64]; o[eb][r] = v; ss += v * v; }
            ss += __shfl_xor(ss, 32);
            const float rs = (1.0f / sqrtf(ss * (1.0f / 128.0f) + EPS)) * (1.0f - LAM_INIT);
            bf16* yp = A.Y + (size_t)qrow * D + A.ycol0 + 4 * h;
#pragma unroll
            for (int eb = 0; eb < NEB; ++eb)
#pragma unroll
                for (int r4 = 0; r4 < 4; ++r4) { const f32x4 g = *(const f32x4*)(dnorm + eb * 32 + 8 * r4 + 4 * h);
                    u32x2 w; w.x = pk2(o[eb][4 * r4] * rs * g[0], o[eb][4 * r4 + 1] * rs * g[1]); w.y = pk2(o[eb][4 * r4 + 2] * rs * g[2], o[eb][4 * r4 + 3] * rs * g[3]);
                    *(u32x2*)(yp + eb * 32 + 8 * r4) = w; }
        }
        __syncthreads();
    }
}

__device__ __forceinline__ void attn_phase(const Args& a, LAS unsigned char* lds, int vcu, int G, int tid) {
    unsigned char* ws = a.ws;
    const bf16* U = (const bf16*)(ws + WS_ACT); bf16* Y = (bf16*)(ws + WS_Y);
    const bf16* CNK = (const bf16*)(ws + WS_CACHE), *CNV = (const bf16*)(ws + WS_CACHE + MiB), *CDK = (const bf16*)(ws + WS_CACHE + 2 * MiB), *CDV = (const bf16*)(ws + WS_CACHE + 3 * MiB);
    const int lane = tid & 63;
    const float* lp = a.in[20];
    const float lam = __expf(wave_sum(lp[lane] * lp[64 + lane])) - __expf(wave_sum(lp[128 + lane] * lp[192 + lane])) + LAM_INIT;
    const float* dnorm = a.in[21];
    for (int u = vcu; u < 256; u += G) {
        const int b = u >> 7, hh = (u >> 5) & 3, qt = u & 31;
        const size_t r0 = (size_t)MCTX + (size_t)b * 4096;
        AttnUnit A;
        A.Q = U + (r0 + qt * 128) * 3072; A.ldq = 3072; A.qcol0 = 1536 + hh * 128; A.qcol1 = A.qcol0 + 64;
        A.K00 = U + r0 * 3072 + 2048 + hh * 128; A.K01 = A.K00 + 64; A.V00 = U + r0 * 3072 + 2560 + hh * 128; A.V01 = A.V00; A.ld0 = 3072; A.nt0 = 64;
        A.K10 = CDK + (size_t)b * 512 * 512 + hh * 128; A.K11 = A.K10 + 64; A.V10 = CDV + (size_t)b * 512 * 512 + hh * 128; A.V11 = A.V10; A.ld1 = 512; A.nt1 = 8;
        A.Y = Y + (r0 + qt * 128) * D; A.ycol0 = 512 + hh * 128; A.ycol1 = A.ycol0;
        A.rq0 = 0; A.krlo = 0; A.rpb = nullptr;
        attn_unit<128, 0>(lds, A, lam, dnorm, tid);
    }
    for (int u = vcu; u < 256; u += G) {
        const int b = u >> 7, hp = (u >> 5) & 3, rp = u & 31;
        const size_t r0 = (size_t)MCTX + (size_t)b * 4096;
        int klo = 2 * rp - 4; klo = klo < 0 ? 0 : (klo > 56 ? 56 : klo);
        int khi = 2 * rp + 1 - 4; khi = khi < 0 ? 0 : (khi > 56 ? 56 : khi);
        AttnUnit A;
        A.Q = U + (r0 + rp * 128) * 3072; A.ldq = 3072; A.qcol0 = hp * 128; A.qcol1 = A.qcol0 + 64;
        A.K00 = CNK + (size_t)b * 512 * 512 + hp * 128; A.K01 = A.K00 + 64; A.V00 = CNV + (size_t)b * 512 * 512 + hp * 128; A.V01 = A.V00 + 64; A.ld0 = 512; A.nt0 = 8;
        A.K10 = U + (r0 + klo * 64) * 3072 + 512 + hp * 128; A.K11 = A.K10 + 64; A.V10 = U + (r0 + klo * 64) * 3072 + 1024 + hp * 128; A.V11 = A.V10 + 64; A.ld1 = 3072; A.nt1 = khi + 8 - klo;
        A.Y = Y + (r0 + rp * 128) * D; A.ycol0 = hp * 128; A.ycol1 = A.ycol0 + 64;
        A.rq0 = 2 * rp; A.krlo = klo; A.rpb = a.in[19] + (size_t)(2 * hp) * 465;
        attn_unit<64, 1>(lds, A, lam, dnorm, tid);
    }
    for (int u = vcu; u < 256; u += G) {
        const int b = u >> 3, hh = (u >> 1) & 3, qt = u & 1;
        const size_t r0 = (size_t)b * 256;
        AttnUnit A;
        A.Q = U + (r0 + qt * 128) * 3072; A.ldq = 3072; A.qcol0 = 1536 + hh * 128; A.qcol1 = A.qcol0 + 64;
        A.K00 = U + r0 * 3072 + 2048 + hh * 128; A.K01 = A.K00 + 64; A.V00 = U + r0 * 3072 + 2560 + hh * 128; A.V01 = A.V00; A.ld0 = 3072; A.nt0 = 4;
        A.K10 = A.K00; A.K11 = A.K01; A.V10 = A.V00; A.V11 = A.V01; A.ld1 = 3072; A.nt1 = 0;
        A.Y = Y + (r0 + qt * 128) * D; A.ycol0 = 512 + hh * 128; A.ycol1 = A.ycol0;
        A.rq0 = 0; A.krlo = 0; A.rpb = nullptr;
        attn_unit<128, 0>(lds, A, lam, dnorm, tid);
    }
    for (int u = vcu; u < 256; u += G) {
        const int b = u >> 3, hp = (u >> 1) & 3, qt = u & 1;
        const size_t r0 = (size_t)b * 256;
        AttnUnit A;
        A.Q = U + (r0 + qt * 128) * 3072; A.ldq = 3072; A.qcol0 = hp * 128; A.qcol1 = A.qcol0 + 64;
        A.K00 = U + r0 * 3072 + 512 + hp * 128; A.K01 = A.K00 + 64; A.V00 = U + r0 * 3072 + 1024 + hp * 128; A.V01 = A.V00 + 64; A.ld0 = 3072; A.nt0 = 4;
        A.K10 = A.K00; A.K11 = A.K01; A.V10 = A.V00; A.V11 = A.V01; A.ld1 = 3072; A.nt1 = 0;
        A.Y = Y + (r0 + qt * 128) * D; A.ycol0 = hp * 128; A.ycol1 = A.ycol0 + 64;
        A.rq0 = 0; A.krlo = 0; A.rpb = nullptr;
        attn_unit<64, 0>(lds, A, lam, dnorm, tid);
    }
}


#define XB_TMO      128
#define XB_XCNT(j)  (256  + 64 * (j))
#define XB_XSUB(j)  (1280 + 64 * (j))
#define XB_XGEN(j)  (2304 + 64 * (j))
#define XB_TOP      3328
#define XB_TOPGEN   3392
#define XCD_BAR_WORDS 3456
#define XB_SPIN_CAP (1u << 18)

__device__ __forceinline__ unsigned xb_ld(unsigned* p)              { return __hip_atomic_load(p, __ATOMIC_RELAXED, __HIP_MEMORY_SCOPE_AGENT); }
__device__ __forceinline__ unsigned xb_add(unsigned* p, unsigned v) { return __hip_atomic_fetch_add(p, v, __ATOMIC_RELAXED, __HIP_MEMORY_SCOPE_AGENT); }
__device__ __forceinline__ unsigned xb_xcc_id() { return (unsigned)__builtin_amdgcn_s_getreg((3 << 11) | 20) & 0xFu; }
#define XB_SPIN(cond, bar) do { unsigned _sp = 0; while (cond) { __builtin_amdgcn_s_sleep(1); \
    if ((++_sp & 255u) == 0u) { if (xb_ld(&(bar)[XB_TMO])) break; if (_sp > XB_SPIN_CAP) { atomicAdd(&(bar)[XB_TMO], 1u); break; } } } } while (0)

struct XcdBarrier {
    unsigned* bar; unsigned x;
    volatile LAS unsigned* st;
};

__device__ __forceinline__ XcdBarrier xcd_barrier_post(unsigned* bar, volatile LAS unsigned* st) {
    XcdBarrier b; b.bar = bar; b.x = xb_xcc_id(); b.st = st;
    if (threadIdx.x == 0) (void)xb_add(&bar[XB_XCNT(b.x)], 1u);
    return b;
}
__device__ __forceinline__ void xcd_barrier_complete(unsigned* bar, unsigned x, unsigned& nloc, unsigned& nx) {
    const unsigned G = gridDim.x * gridDim.y * gridDim.z;
    unsigned sum, cnt, mine, sp = 0u;
    for (;;) {
        sum = 0u; cnt = 0u; mine = 0u;
#pragma unroll
        for (unsigned j = 0; j < 16; ++j) { const unsigned c = xb_ld(&bar[XB_XCNT(j)]); sum += c; cnt += (c > 0u) ? 1u : 0u; mine = (j == x) ? c : mine; }
        if (sum == G) break;
        __builtin_amdgcn_s_sleep(1);
        if ((++sp & 255u) == 0u) { if (xb_ld(&bar[XB_TMO])) break; if (sp > XB_SPIN_CAP) { atomicAdd(&bar[XB_TMO], 1u); break; } }
    }
    nloc = mine > 0u ? mine : 1u; nx = cnt > 0u ? cnt : 1u;
}

__device__ __forceinline__ void xcd_barrier(const XcdBarrier& b) {
    asm volatile("s_waitcnt vmcnt(0)" ::: "memory");
    __syncthreads();
    if (threadIdx.x == 0) {
        unsigned* bar = b.bar;
        __builtin_amdgcn_s_waitcnt(0);
        unsigned nloc = b.st[0], nx = b.st[1];
        if (nloc == 0u) { xcd_barrier_complete(bar, b.x, nloc, nx); b.st[0] = nloc; b.st[1] = nx; }
        const unsigned old = xb_add(&bar[XB_XSUB(b.x)], 1u);
        const unsigned gen = old / nloc;
        if (old + 1u == (gen + 1u) * nloc) {
            __builtin_amdgcn_fence(__ATOMIC_RELEASE, "agent");
            asm volatile("s_waitcnt vmcnt(0)" ::: "memory");
            const unsigned og = xb_add(&bar[XB_TOP], 1u);
            const unsigned tg = og / nx;
            if (og + 1u == (tg + 1u) * nx) xb_add(&bar[XB_TOPGEN], 1u);
            else XB_SPIN(xb_ld(&bar[XB_TOPGEN]) == tg, bar);
            __builtin_amdgcn_fence(__ATOMIC_ACQUIRE, "agent");
            xb_add(&bar[XB_XGEN(b.x)], 1u);
            asm volatile("s_waitcnt vmcnt(0)" ::: "memory");
        } else {
            XB_SPIN(xb_ld(&bar[XB_XGEN(b.x)]) == gen, bar);
            __builtin_amdgcn_fence(__ATOMIC_ACQUIRE, "agent");
            asm volatile("s_waitcnt vmcnt(0)" ::: "memory");
        }
    }
    __syncthreads();
}

#ifndef REP_SYNC
#define REP_SYNC 1
#endif
#ifndef REP_ATTN
#define REP_ATTN 1
#endif
#ifndef REP_P0
#define REP_P0 1
#endif
#ifndef REP_NORM
#define REP_NORM 1
#endif
#ifndef REP_FFNIN
#define REP_FFNIN 1
#endif
#ifndef REP_EVEN
#define REP_EVEN 1
#endif
#define GSYNC() do { for (int rs_ = 0; rs_ < REP_SYNC; ++rs_) xcd_barrier(xbar); } while (0)
__global__ void __launch_bounds__(NTHR, 2) hybrid_fwd(Args a) {
    extern __shared__ __attribute__((aligned(16))) unsigned char lds_raw[];
    LAS unsigned char* lds = (LAS unsigned char*)lds_raw;
    cg::grid_group grid = cg::this_grid();
    const int tid = threadIdx.x, lane = tid & 63, wave = __builtin_amdgcn_readfirstlane(tid >> 6);
    const int G = gridDim.x, bx = blockIdx.x;
    const int vcu = (G % 8 == 0) ? (bx % 8) * (G / 8) + bx / 8 : bx;
    const int gw = vcu * NWAVES + wave, NGW = G * NWAVES;
    unsigned char* ws = a.ws;
    float* X = a.out;
    float* mods = (float*)(ws + WS_MODS);
    bf16* H = (bf16*)(ws + WS_H); bf16* Y = (bf16*)(ws + WS_Y); bf16* ACT = (bf16*)(ws + WS_ACT);

    unsigned* barw = (unsigned*)ws;
    volatile LAS unsigned* bst = (volatile LAS unsigned*)(lds + 131072 + 64);
    if (bx == 0) for (int i = tid; i < XCD_BAR_WORDS; i += NTHR) barw[i] = 0u;
    if (tid < 2) bst[tid] = 0u;
    __syncthreads();
#ifndef NO_P0
    for (int rp_ = 0; rp_ < REP_P0; ++rp_) {
    p0_mods(a, lds, tid);
    p0_weights(a, lds, gw, NGW, wave, lane);
    }
#endif
    grid.sync();
    const XcdBarrier xbar = xcd_barrier_post(barw, bst);

#pragma unroll
    for (int l = 0; l < 2; ++l) {
        const float* ml = mods + (size_t)l * 3 * NMOD;
#pragma unroll
        for (int part = 0; part < 3; ++part) {
            const bool first = (l == 0 && part == 0);
            const float* bc = first ? a.in[0] : X; const float* bl = first ? a.in[1] : X + (size_t)MCTX * D;
            if (part != 1) {
                const int f = part >> 1;
                const float* g = a.in[f ? 23 : 10] + (size_t)l * D;
                for (int rp_ = 0; rp_ < REP_NORM; ++rp_)
                norm_phase(bc, bl, g, ml + (f ? 6 : 0) * D, ml + (f ? 7 : 1) * D, H, gw, NGW, lane);
                GSYNC();
                const bf16* Win = (const bf16*)(ws + WS_WF + (size_t)(l * 2 + f) * 17 * MiB); const bf16* Wout = (const bf16*)((const unsigned char*)Win + 11 * MiB);
#ifndef NO_SWG
                for (int rp_ = 0; rp_ < REP_FFNIN; ++rp_)
                { EpiSwiglu E{ACT}; run_gemm(lds, H, Win, 2 * FF, D, E); }
#endif
                GSYNC();
#ifndef NO_RES1
                { EpiResid E{bc, bl, X, ml + (f ? 8 : 2) * D, 0.5f}; run_gemm(lds, ACT, Wout, D, FF, E); }
#endif
                GSYNC();
            } else {
                for (int rp_ = 0; rp_ < REP_NORM; ++rp_)
                norm_phase(bc, bl, a.in[13] + (size_t)l * D, ml + 3 * D, ml + 4 * D, H, gw, NGW, lane);
                GSYNC();
                if (l == 0) {
#ifndef NO_EVG
                    { EpiBf16P E{ACT, 2048}; run_gemm(lds, H, (const bf16*)(ws + WS_WMI0), 2048, D, E); }
#endif
                    GSYNC();
#ifndef NO_EVEN
                    for (int rp_ = 0; rp_ < REP_EVEN; ++rp_)
                    even_core_phase(ACT, a.in[17], Y, vcu * NTHR + tid, G * NTHR);
#endif
                } else {
#ifndef NO_ODDG
                    { EpiOdd E{ACT, a.out + (size_t)M * D, (const float*)(ws + WS_ROPE)}; run_gemm(lds, H, (const bf16*)(ws + WS_WMI1), 3072, D, E); }
#endif
                    GSYNC();
#ifndef NO_ATTN
                    for (int rp_ = 0; rp_ < REP_ATTN; ++rp_)
                    attn_phase(a, lds, vcu, G, tid);
#endif
                }
                GSYNC();
#ifndef NO_RES2
                { EpiResid E{bc, bl, X, ml + 5 * D, 1.0f}; run_gemm(lds, Y, (const bf16*)(ws + (l == 0 ? WS_WMO0 : WS_WMO1)), D, D, E); }
#endif
                GSYNC();
            }
        }
    }
    final_norm_phase(X, a.in[26], gw, NGW, lane);
}

extern "C" void kernel_launch(void* const* d_in, const int* in_sizes, int n_in, void* d_out, int out_size, void* d_ws, size_t ws_size, hipStream_t stream) {
    static int grid = 0;
    if (grid == 0) {
        if (n_in != 27 || ws_size < WS_END) { fprintf(stderr, "kernel_launch: unexpected n_in %d / ws_size %zu\n", n_in, ws_size); grid = -1; return; }
        int dev = 0, cus = 0, per_cu = 0;
        (void)hipGetDevice(&dev); (void)hipDeviceGetAttribute(&cus, hipDeviceAttributeMultiprocessorCount, dev);
        if (hipFuncSetAttribute((const void*)hybrid_fwd, hipFuncAttributeMaxDynamicSharedMemorySize, LDS_BYTES) != hipSuccess) { fprintf(stderr, "kernel_launch: hipFuncSetAttribute failed\n"); grid = -1; return; }
        if (hipOccupancyMaxActiveBlocksPerMultiprocessor(&per_cu, (const void*)hybrid_fwd, NTHR, LDS_BYTES) != hipSuccess || per_cu < 1) { fprintf(stderr, "kernel_launch: occupancy query says %d\n", per_cu); per_cu = 1; }
        (void)hipGetLastError();
        grid = cus * per_cu;
        fprintf(stderr, "kernel_launch: grid %d (cus %d x %d)\n", grid, cus, per_cu);
    }
    if (grid < 0) return;
    Args a{};
    for (int i = 0; i < 27; ++i) a.in[i] = (const float*)d_in[i];
    a.out = (float*)d_out; a.ws = (unsigned char*)d_ws;
    void* kargs[] = {&a};
    hipError_t e = hipLaunchCooperativeKernel((const void*)hybrid_fwd, dim3(grid), dim3(NTHR), kargs, LDS_BYTES, stream);
    if (e != hipSuccess) fprintf(stderr, "kernel_launch: cooperative launch failed: %s (grid %d)\n", hipGetErrorString(e), grid);
}
```
